# Optimizing an MI355X kernel written in HIP

```python
import math
import jax, jax.numpy as jnp
from jax import lax
import numpy as np

D_MODEL = 1024
BATCH = 8
SEQ = 2048
DEPTH = 4
DEC_BATCH = 128
DEC_SEQ = 4
PAST_LEN = 8192
PAGE_SIZE = 128

N_META = 16
HEAD_DIM = 64
N_Q_HEADS = 8
N_KV_HEADS = 2
GQA_GROUP = N_Q_HEADS // N_KV_HEADS
ATTN_W = N_Q_HEADS * HEAD_DIM
KV_W = N_KV_HEADS * HEAD_DIM
LRU_W = D_MODEL - ATTN_W
LRU_BLOCKS = 8
LRU_BLOCK_W = LRU_W // LRU_BLOCKS
CONV_W = 4
LRU_C = 8.0
WINDOW = 128
BLOCK = 128
ROPE_THETA = 10000.0
D_FF = -(-8 * D_MODEL // (3 * 256)) * 256
IN_W = ATTN_W + 2 * KV_W + 2 * LRU_W
MIX_W = ATTN_W + LRU_W
EPS = 1e-6

kernel_name = "hymba_griffin_swa_sink_step"


def rms_norm(x, g):
    xf = x.astype(jnp.float32)
    y = xf * lax.rsqrt(jnp.mean(xf * xf, axis=-1, keepdims=True) + EPS)
    return (y * g.astype(jnp.float32)).astype(x.dtype)


def rope(x, pos):
    half = HEAD_DIM // 2
    inv = ROPE_THETA ** (-jnp.arange(half, dtype=jnp.float32) / half)
    ang = pos.astype(jnp.float32)[:, None] * inv[None, :]
    cos = jnp.cos(ang)[:, None, :]
    sin = jnp.sin(ang)[:, None, :]
    xf = x.astype(jnp.float32)
    x1, x2 = xf[..., :half], xf[..., half:]
    out = jnp.concatenate([x1 * cos - x2 * sin, x2 * cos + x1 * sin], axis=-1)
    return out.astype(x.dtype)


def sink_softmax(s, sink):
    m = jnp.maximum(jnp.max(s, axis=-1, keepdims=True), sink)
    p = jnp.exp(s - m)
    return p / (jnp.sum(p, axis=-1, keepdims=True) + jnp.exp(sink - m))


def swa_prompt(q, k, v, sinks):
    B, L = q.shape[0], q.shape[1]
    pad = (-L) % BLOCK
    padw = ((0, 0), (pad, 0), (0, 0), (0, 0))
    qp, kp, vp = jnp.pad(q, padw), jnp.pad(k, padw), jnp.pad(v, padw)
    nb = (L + pad) // BLOCK
    qb = qp.reshape(B, nb, BLOCK, N_KV_HEADS, GQA_GROUP, HEAD_DIM)
    kb = kp.reshape(B, nb, BLOCK, N_KV_HEADS, HEAD_DIM)
    vb = vp.reshape(B, nb, BLOCK, N_KV_HEADS, HEAD_DIM)
    shift = ((0, 0), (1, 0), (0, 0), (0, 0), (0, 0))
    kk = jnp.concatenate([jnp.pad(kb, shift)[:, :-1], kb], axis=2)
    vv = jnp.concatenate([jnp.pad(vb, shift)[:, :-1], vb], axis=2)
    s = jnp.einsum('bnqkgd,bnskd->bnkgqs', qb, kk,
                   preferred_element_type=jnp.float32) * (HEAD_DIM ** -0.5)
    i = jnp.arange(BLOCK)[:, None]
    j = jnp.arange(2 * BLOCK)[None, :]
    n = jnp.arange(nb)[:, None, None]
    kidx = (n - 1) * BLOCK + j - pad
    rel = BLOCK + i - j
    mask = (kidx >= 0) & (rel >= 0) & (rel < WINDOW)
    s = jnp.where(mask[None, :, None, None], s, -jnp.inf)
    sink = sinks.astype(jnp.float32).reshape(N_KV_HEADS, GQA_GROUP)[:, :, None, None]
    p = sink_softmax(s, sink)
    o = jnp.einsum('bnkgqs,bnskd->bnqkgd', p.astype(v.dtype), vv)
    return o.reshape(B, L + pad, ATTN_W)[:, pad:]


def swa_sample(q, k_new, v_new, k_buf, v_buf, sinks, pos):
    B, S = q.shape[0], q.shape[1]
    kk = jnp.concatenate([k_buf.astype(k_new.dtype), k_new], axis=1)
    vv = jnp.concatenate([v_buf.astype(v_new.dtype), v_new], axis=1)
    kpos = jnp.concatenate([pos[0] - WINDOW + jnp.arange(WINDOW, dtype=pos.dtype), pos])
    rel = pos[:, None] - kpos[None, :]
    mask = (kpos[None, :] >= 0) & (rel >= 0) & (rel < WINDOW)
    qg = q.reshape(B, S, N_KV_HEADS, GQA_GROUP, HEAD_DIM)
    s = jnp.einsum('bqkgd,bskd->bkgqs', qg, kk,
                   preferred_element_type=jnp.float32) * (HEAD_DIM ** -0.5)
    s = jnp.where(mask, s, -jnp.inf)
    sink = sinks.astype(jnp.float32).reshape(N_KV_HEADS, GQA_GROUP)[:, :, None, None]
    p = sink_softmax(s, sink)
    o = jnp.einsum('bkgqs,bskd->bqkgd', p.astype(vv.dtype), vv)
    return o.reshape(B, S, ATTN_W), kk[:, -WINDOW:], vv[:, -WINDOW:]


def rg_lru(xb, conv_prefix, h0, conv_w, conv_b, w_a, b_a, w_i, b_i, lam):
    B, L = xb.shape[0], xb.shape[1]
    xc = jnp.concatenate([conv_prefix.astype(xb.dtype), xb], axis=1)
    u = conv_b.astype(xb.dtype)
    for j in range(CONV_W):
        u = u + xc[:, j:j + L] * conv_w[j].astype(xb.dtype)
    new_conv = xc[:, -(CONV_W - 1):]
    ub = u.reshape(B, L, LRU_BLOCKS, LRU_BLOCK_W)
    r = jax.nn.sigmoid((jnp.einsum('blhi,hij->blhj', ub, w_a).reshape(B, L, LRU_W)
                        + b_a).astype(jnp.float32))
    ig = jax.nn.sigmoid((jnp.einsum('blhi,hij->blhj', ub, w_i).reshape(B, L, LRU_W)
                         + b_i).astype(jnp.float32))
    log_a = LRU_C * r * jax.nn.log_sigmoid(lam.astype(jnp.float32))
    a = jnp.exp(log_a)
    bt = jnp.sqrt(-jnp.expm1(2.0 * log_a)) * ig * u.astype(jnp.float32)

    def step(h, ab):
        a_t, b_t = ab
        h = a_t * h + b_t
        return h, h

    hT, hs = lax.scan(step, h0.astype(jnp.float32),
                      (jnp.swapaxes(a, 0, 1), jnp.swapaxes(bt, 0, 1)))
    return jnp.swapaxes(hs, 0, 1).astype(xb.dtype), hT, new_conv


def decoder_stack(x, pos, k_bufs, v_bufs, h0s, conv0s,
                  pre_mix_norm, w_in, sinks, conv_w, conv_b, w_a, b_a, w_i, b_i, lam,
                  attn_out_norm, lru_out_norm, w_out, post_mix_norm,
                  pre_ffn_norm, w_gate, w_up, w_down, post_ffn_norm):
    B, L = x.shape[0], x.shape[1]
    splits = [ATTN_W, ATTN_W + KV_W, ATTN_W + 2 * KV_W, ATTN_W + 2 * KV_W + LRU_W]
    nks, nvs, nhs, ncs = [], [], [], []
    for l in range(DEPTH):
        hn = rms_norm(x, pre_mix_norm[l])
        z = hn @ w_in[l]
        q, k, v, xb, gate = jnp.split(z, splits, axis=-1)
        q = rope(q.reshape(B, L, N_Q_HEADS, HEAD_DIM), pos)
        k = rope(k.reshape(B, L, N_KV_HEADS, HEAD_DIM), pos)
        v = v.reshape(B, L, N_KV_HEADS, HEAD_DIM)
        if k_bufs is None:
            o_att = swa_prompt(q, k, v, sinks[l])
            nk, nv = k[:, -WINDOW:], v[:, -WINDOW:]
        else:
            o_att, nk, nv = swa_sample(q, k, v, k_bufs[l], v_bufs[l], sinks[l], pos)
        h_seq, hT, nconv = rg_lru(xb, conv0s[l], h0s[l], conv_w[l], conv_b[l],
                                  w_a[l], b_a[l], w_i[l], b_i[l], lam[l])
        o_lru = h_seq * jax.nn.gelu(gate, approximate=True)
        merged = jnp.concatenate([rms_norm(o_att, attn_out_norm[l]),
                                  rms_norm(o_lru, lru_out_norm[l])], axis=-1)
        x = x + rms_norm(merged @ w_out[l], post_mix_norm[l])
        hf = rms_norm(x, pre_ffn_norm[l])
        f = (jax.nn.silu(hf @ w_gate[l]) * (hf @ w_up[l])) @ w_down[l]
        x = x + rms_norm(f, post_ffn_norm[l])
        nks.append(nk); nvs.append(nv); nhs.append(hT); ncs.append(nconv)
    return x, jnp.stack(nks), jnp.stack(nvs), jnp.stack(nhs), jnp.stack(ncs)


def setup_inputs(seed: int = 0) -> dict:
    key = jax.random.key(seed)
    ks = jax.random.split(key, 32)
    f32 = jnp.float32
    nrm = lambda k, shape, s: jax.random.normal(k, shape, f32) * s
    gain = lambda k, shape: 1.0 + 0.01 * jax.random.normal(k, shape, f32)
    u = jax.random.uniform(ks[0], (DEPTH, LRU_W), f32, 0.9, 0.999)
    a0 = u ** (1.0 / LRU_C)
    lam = jnp.log(a0) - jnp.log1p(-a0)
    return {
        "x_prompt": nrm(ks[1], (BATCH, SEQ, D_MODEL), 1.0),
        "x_sample": nrm(ks[2], (DEC_BATCH, DEC_SEQ, D_MODEL), 1.0),
        "cache_k": nrm(ks[3], (DEPTH, DEC_BATCH, WINDOW, N_KV_HEADS, HEAD_DIM), 1.0),
        "cache_v": nrm(ks[4], (DEPTH, DEC_BATCH, WINDOW, N_KV_HEADS, HEAD_DIM), 1.0),
        "state_h": nrm(ks[5], (DEPTH, DEC_BATCH, LRU_W), 0.5),
        "state_conv": nrm(ks[6], (DEPTH, DEC_BATCH, CONV_W - 1, LRU_W), 1.0),
        "meta_tokens": nrm(ks[7], (N_META, D_MODEL), 1.0),
        "pre_mix_norm": gain(ks[8], (DEPTH, D_MODEL)),
        "w_in": nrm(ks[9], (DEPTH, D_MODEL, IN_W), D_MODEL ** -0.5),
        "sinks": nrm(ks[10], (DEPTH, N_Q_HEADS), 0.5),
        "conv_w": nrm(ks[11], (DEPTH, CONV_W, LRU_W), CONV_W ** -0.5),
        "conv_b": nrm(ks[12], (DEPTH, LRU_W), 0.01),
        "w_a": nrm(ks[13], (DEPTH, LRU_BLOCKS, LRU_BLOCK_W, LRU_BLOCK_W), LRU_BLOCK_W ** -0.5),
        "b_a": nrm(ks[14], (DEPTH, LRU_W), 0.01),
        "w_i": nrm(ks[15], (DEPTH, LRU_BLOCKS, LRU_BLOCK_W, LRU_BLOCK_W), LRU_BLOCK_W ** -0.5),
        "b_i": nrm(ks[16], (DEPTH, LRU_W), 0.01),
        "lam": lam,
        "attn_out_norm": gain(ks[17], (DEPTH, ATTN_W)),
        "lru_out_norm": gain(ks[18], (DEPTH, LRU_W)),
        "w_out": nrm(ks[19], (DEPTH, MIX_W, D_MODEL), MIX_W ** -0.5),
        "post_mix_norm": gain(ks[20], (DEPTH, D_MODEL)),
        "pre_ffn_norm": gain(ks[21], (DEPTH, D_MODEL)),
        "w_gate": nrm(ks[22], (DEPTH, D_MODEL, D_FF), D_MODEL ** -0.5),
        "w_up": nrm(ks[23], (DEPTH, D_MODEL, D_FF), D_MODEL ** -0.5),
        "w_down": nrm(ks[24], (DEPTH, D_FF, D_MODEL), D_FF ** -0.5),
        "post_ffn_norm": gain(ks[25], (DEPTH, D_MODEL)),
    }


def reference(x_prompt, x_sample, cache_k, cache_v, state_h, state_conv, meta_tokens,
              pre_mix_norm, w_in, sinks, conv_w, conv_b, w_a, b_a, w_i, b_i, lam,
              attn_out_norm, lru_out_norm, w_out, post_mix_norm,
              pre_ffn_norm, w_gate, w_up, w_down, post_ffn_norm):
    weights = (pre_mix_norm, w_in, sinks, conv_w, conv_b, w_a, b_a, w_i, b_i, lam,
               attn_out_norm, lru_out_norm, w_out, post_mix_norm,
               pre_ffn_norm, w_gate, w_up, w_down, post_ffn_norm)
    B = x_prompt.shape[0]
    meta = jnp.broadcast_to(meta_tokens.astype(x_prompt.dtype)[None], (B, N_META, D_MODEL))
    xp = jnp.concatenate([meta, x_prompt], axis=1)
    pos_p = jnp.arange(xp.shape[1], dtype=jnp.int32)
    h0 = jnp.zeros((DEPTH, B, LRU_W), jnp.float32)
    c0 = jnp.zeros((DEPTH, B, CONV_W - 1, LRU_W), x_prompt.dtype)
    yp, prompt_k, prompt_v, prompt_h, prompt_conv = decoder_stack(
        xp, pos_p, None, None, h0, c0, *weights)
    y_prompt = yp[:, N_META:]
    pos_s = PAST_LEN + jnp.arange(x_sample.shape[1], dtype=jnp.int32)
    y_sample, sample_k, sample_v, sample_h, sample_conv = decoder_stack(
        x_sample, pos_s, cache_k, cache_v, state_h, state_conv, *weights)
    return (y_prompt, y_sample, prompt_k, prompt_v, prompt_h, prompt_conv,
            sample_k, sample_v, sample_h, sample_conv)
```

```cpp
#include <hip/hip_runtime.h>
#include <hip/hip_cooperative_groups.h>
#include <cstdio>
#include <cstdint>
namespace cg = cooperative_groups;

constexpr int DM = 1024, NB = 8, SEQ = 2048, LP = 2064, DEPTH = 4, SB = 128, SS = 4, NMETA = 16;
constexpr int ATT_W = 512, LRU_W = 512, D_FF = 2816, IN_W = 1792;
constexpr int MP = NB * LP;
constexpr int MS = SB * SS;
constexpr int MV = MP + MS;
constexpr int MPAD = 17152;
constexpr int NCH = 33;
constexpr int VTP_LD = 2080, VTS_LD = 144, KS_ROWS = 144;
constexpr float EPS = 1e-6f;
constexpr size_t OFF_YP = 0, OFF_YS = OFF_YP + (size_t)NB * SEQ * DM, OFF_PK = OFF_YS + (size_t)MS * DM, OFF_PV = OFF_PK + (size_t)DEPTH * NB * 128 * 128,
                 OFF_PH = OFF_PV + (size_t)DEPTH * NB * 128 * 128, OFF_PC = OFF_PH + (size_t)DEPTH * NB * 512, OFF_SK = OFF_PC + (size_t)DEPTH * NB * 3 * 512,
                 OFF_SV = OFF_SK + (size_t)DEPTH * SB * 128 * 128, OFF_SH = OFF_SV + (size_t)DEPTH * SB * 128 * 128, OFF_SC = OFF_SH + (size_t)DEPTH * SB * 512;
constexpr size_t MiB = 1u << 20;
constexpr size_t WS_CTL = 0, CTL_BYTES = 1 * MiB, WS_XMETA = 1 * MiB, WS_XSS = 2 * MiB, WS_XBUF = 4 * MiB, WS_AGG = 5 * MiB, WS_LRUW = 7 * MiB, WS_W = 8 * MiB;
constexpr size_t W_IN_B = (size_t)IN_W * DM * 2, W_OUT_B = (size_t)DM * DM * 2, W_GU_B = (size_t)2 * D_FF * DM * 2, W_D_B = (size_t)DM * D_FF * 2, W_LAYER_B = W_IN_B + W_OUT_B + W_GU_B + W_D_B;
constexpr size_t WS_XB16 = 96 * MiB, WS_KP = 130 * MiB, WS_VTP = 135 * MiB, WS_KS = 140 * MiB, WS_VTS = 158 * MiB;
constexpr size_t WS_Q = 176 * MiB, WS_XBC = 193 * MiB, WS_G = 210 * MiB, WS_PL = 252 * MiB + 256 * 1024, WS_MRG = 269 * MiB + 256 * 1024, WS_HACT = 176 * MiB, WS_GT = 303 * MiB, WS_END = 304 * MiB;
constexpr long TAIL_ROW0 = 16384, G_DELTA = (long)((WS_GT - WS_G) / 2) - TAIL_ROW0 * 512;
static_assert(WS_PL + (size_t)TAIL_ROW0 * 1024 >= WS_HACT + (size_t)MPAD * D_FF * 2 && WS_PL + (size_t)MPAD * 1024 <= WS_MRG && WS_MRG + (size_t)MPAD * 2048 <= WS_GT, "tail rows outside the hact overlay");
static_assert(WS_W + 4 * W_LAYER_B <= WS_XB16 && WS_HACT + (size_t)MPAD * D_FF * 2 <= WS_END, "ws map");
constexpr int CW_SEAM = 4096, SEAM_BANK = 128 * 64, CW_READY = 131072, CW_GDONE = 196608, CW_XBAR = 200704, CW_XCC = 208896, CW_GD16 = 212992, CW_SLAB = 221184, CW_GRP = 253952;

typedef unsigned short bf16_t;
typedef short bf16x8 __attribute__((ext_vector_type(8)));
typedef short bf16x4 __attribute__((ext_vector_type(4)));
typedef float f32x4 __attribute__((ext_vector_type(4)));
typedef float f32x2 __attribute__((ext_vector_type(2)));
typedef unsigned u32x4 __attribute__((ext_vector_type(4)));
typedef unsigned u32x2 __attribute__((ext_vector_type(2)));

__device__ __forceinline__ unsigned cvt_pk_bf16(float lo, float hi) { unsigned r; asm volatile("v_cvt_pk_bf16_f32 %0, %1, %2" : "=v"(r) : "v"(lo), "v"(hi)); return r; }
__device__ __forceinline__ float bf2f(unsigned short b) { return __uint_as_float((unsigned)b << 16); }
__device__ __forceinline__ float bflo(unsigned w) { return __uint_as_float(w << 16); }
__device__ __forceinline__ float bfhi(unsigned w) { return __uint_as_float(w & 0xffff0000u); }
__device__ __forceinline__ float gelu_tanh(float x) { const float y = 0.7978845608f * (x + 0.044715f * x * x * x); return x * __builtin_amdgcn_rcpf(1.f + __expf(-2.f * y)); }
__device__ __forceinline__ float sigmoidf_(float x) { return __builtin_amdgcn_rcpf(1.f + __expf(-x)); }
__device__ __forceinline__ float wave_sum(float v) {
#pragma unroll
    for (int o = 1; o < 64; o <<= 1) v += __shfl_xor(v, o);
    return v;
}
__device__ __forceinline__ float* xrow_ptr(float* out, float* xmeta, int row) {
    if (row < MP) { const int b = row / LP, t = row - b * LP; return t >= NMETA ? out + OFF_YP + ((size_t)b * SEQ + (t - NMETA)) * DM : xmeta + (size_t)(b * NMETA + t) * DM; }
    if (row < MV) return out + OFF_YS + (size_t)(row - MP) * DM;
    return xmeta + (size_t)(128 + row - MV) * DM;
}
namespace pg8 {
#define PG8_LAS __attribute__((address_space(3)))
typedef unsigned short bf16_t;
typedef short bf16x8 __attribute__((ext_vector_type(8)));
typedef float f32x4 __attribute__((ext_vector_type(4)));
typedef unsigned u32x4 __attribute__((ext_vector_type(4)));
constexpr int BM = 256, BK = 64, HALF = 128, HTB = HALF * BK * 2  , STAGE_BYTES = 8 * HTB, NXCD = 8, WGM = 8;

__host__ __device__ __forceinline__ int lds_byte(int r, int c) { const int st = (r >> 4) * 2 + (c >> 5), rr = r & 15, cc = c & 31, ob = rr * 64 + cc * 2; return st * 1024 + (ob ^ (((ob >> 9) & 1) << 5)); }
__host__ __device__ __forceinline__ void stage_rc(int b, int& R, int& C) { const int st = b / 1024, sb = b % 1024, swz = sb ^ (((sb >> 9) & 1) << 5); R = (st >> 1) * 16 + swz / 64; C = (st & 1) * 32 + (swz % 64) / 2; }
__host__ __device__ __forceinline__ int perm32(int rho) { const int n = rho >> 4, i = rho & 15; return 8 * (i >> 2) + 4 * n + (i & 3); }

struct Unit { int pm, pn; };
struct Gemm { const bf16_t* A; const bf16_t* Bt; int M, N, K; };

struct StaticOrder {
    int nM, nN, nwg, G, c;
    __host__ __device__ void init(int M, int N, int G_, int c_) { nM = M / BM; nN = N / BM; nwg = nM * nN; G = G_; c = c_; }
    __host__ __device__ bool next(int i, Unit& u) const {
        const long L = (long)i * G + c; if (L >= nwg) return false;
        int wgid = (int)L; { const int q = nwg / NXCD, r = nwg % NXCD, xcd = wgid % NXCD, off = wgid / NXCD; wgid = (xcd < r ? xcd * (q + 1) : r * (q + 1) + (xcd - r) * q) + off; }
        const int nig = WGM * nN, gid = wgid / nig, fm = gid * WGM, gsz = (nM - fm) < WGM ? (nM - fm) : WGM;
        u.pm = fm + ((wgid % nig) % gsz); u.pn = (wgid % nig) / gsz; return true;
    }
    __device__ __forceinline__ void a_ready(const Unit&) const {}
    __device__ __forceinline__ void done(const Unit&) const {}
};

__device__ __forceinline__ float row_rs(const float* xss, int row) {
    const f32x4 a = *(const f32x4*)(xss + (size_t)row * 4);
    return rsqrtf(((a[0] + a[1]) + (a[2] + a[3])) * (1.0f / 1024.0f) + EPS);
}
struct EpiIn {
    static constexpr bool PERM = true, AFTER_DRAIN = false;
    const float* xss; bf16_t *q, *kP, *vTP, *kS, *vTS, *xbc, *G; float* out; int layer;
    __device__ __forceinline__ void operator()(const f32x4 (&acc)[2][2][4][2], const Unit& u, int wr, int wc, int fr, int fq) const {
        const int l = layer;
        float rsv[2][4];
#pragma unroll
        for (int ai = 0; ai < 2; ++ai)
#pragma unroll
            for (int m = 0; m < 4; ++m) rsv[ai][m] = row_rs(xss, u.pm * BM + ai * HALF + wr * 64 + m * 16 + fr);
#pragma unroll
        for (int ai = 0; ai < 2; ++ai)
#pragma unroll
            for (int m = 0; m < 4; ++m) {
                const int row = u.pm * BM + ai * HALF + wr * 64 + m * 16 + fr;
                const float rs = rsv[ai][m];
                int kind, b, t; float pos;
                if (row < MP) { kind = 0; b = row / LP; t = row - b * LP; pos = (float)t; } else if (row < MV) { kind = 1; b = (row - MP) >> 2; t = (row - MP) & 3; pos = (float)(8192 + t); } else { kind = 2; b = 0; t = 0; pos = 0.f; }
                if (u.pn <= 2) {
                    float cs[4], sn[4];
                    if (u.pn < 2 || true) {
#pragma unroll
                        for (int j = 0; j < 4; ++j) { const int d = 16 * (wc & 1) + 4 * fq + j; const float inv = exp2f(-(float)d * 0.4152410118609203f); const float ang = pos * inv;
                            double rv = (double)ang * 0.15915494309189535; rv -= floor(rv); const float fv = (float)rv; cs[j] = __builtin_amdgcn_cosf(fv); sn[j] = __builtin_amdgcn_sinf(fv); }
                    }
                    if (u.pn < 2) {
#pragma unroll
                        for (int bj = 0; bj < 2; ++bj) { const int head = 4 * u.pn + 2 * bj + (wc >> 1); const f32x4 x1 = acc[ai][bj][m][0] * rs, x2 = acc[ai][bj][m][1] * rs; float o1[4], o2[4];
#pragma unroll
                            for (int j = 0; j < 4; ++j) { o1[j] = (x1[j] * cs[j] - x2[j] * sn[j]) * 0.125f; o2[j] = (x2[j] * cs[j] + x1[j] * sn[j]) * 0.125f; }
                            bf16_t* qp = q + (size_t)row * 512 + head * 64 + 16 * (wc & 1) + 4 * fq;
                            *(u32x2*)qp = (u32x2){cvt_pk_bf16(o1[0], o1[1]), cvt_pk_bf16(o1[2], o1[3])}; *(u32x2*)(qp + 32) = (u32x2){cvt_pk_bf16(o2[0], o2[1]), cvt_pk_bf16(o2[2], o2[3])}; }
                    } else {
                        const int kvh = wc >> 1, d0 = 16 * (wc & 1) + 4 * fq;
                        { const f32x4 x1 = acc[ai][0][m][0] * rs, x2 = acc[ai][0][m][1] * rs; f32x4 o1, o2;
#pragma unroll
                            for (int j = 0; j < 4; ++j) { o1[j] = x1[j] * cs[j] - x2[j] * sn[j]; o2[j] = x2[j] * cs[j] + x1[j] * sn[j]; }
                            const u32x2 w1 = (u32x2){cvt_pk_bf16(o1[0], o1[1]), cvt_pk_bf16(o1[2], o1[3])}, w2 = (u32x2){cvt_pk_bf16(o2[0], o2[1]), cvt_pk_bf16(o2[2], o2[3])};
                            if (kind == 0) { bf16_t* kp = kP + (size_t)row * 128 + kvh * 64 + d0; *(u32x2*)kp = w1; *(u32x2*)(kp + 32) = w2;
                                if (t >= LP - 128) { float* op = out + OFF_PK + ((size_t)(l * NB + b) * 128 + (t - (LP - 128))) * 128 + kvh * 64 + d0; *(f32x4*)op = o1; *(f32x4*)(op + 32) = o2; } }
                            else if (kind == 1) { bf16_t* kp = kS + ((size_t)(l * SB + b) * KS_ROWS + 128 + t) * 128 + kvh * 64 + d0; *(u32x2*)kp = w1; *(u32x2*)(kp + 32) = w2;
                                float* op = out + OFF_SK + ((size_t)(l * SB + b) * 128 + 124 + t) * 128 + kvh * 64 + d0; *(f32x4*)op = o1; *(f32x4*)(op + 32) = o2; } }
#pragma unroll
                        for (int n = 0; n < 2; ++n) { const f32x4 v = acc[ai][1][m][n] * rs; const int d = 32 * (wc & 1) + 8 * fq + 4 * n;
                            if (kind == 0) { bf16_t* vp = vTP + ((size_t)(b * 2 + kvh) * 64 + d) * VTP_LD + t;
#pragma unroll
                                for (int j = 0; j < 4; ++j) vp[(size_t)j * VTP_LD] = (bf16_t)(cvt_pk_bf16(v[j], 0.f) & 0xffffu);
                                if (t >= LP - 128) *(f32x4*)(out + OFF_PV + ((size_t)(l * NB + b) * 128 + (t - (LP - 128))) * 128 + kvh * 64 + d) = v; }
                            else if (kind == 1) { bf16_t* vp = vTS + ((size_t)((l * SB + b) * 2 + kvh) * 64 + d) * VTS_LD + 128 + t;
#pragma unroll
                                for (int j = 0; j < 4; ++j) vp[(size_t)j * VTS_LD] = (bf16_t)(cvt_pk_bf16(v[j], 0.f) & 0xffffu);
                                *(f32x4*)(out + OFF_SV + ((size_t)(l * SB + b) * 128 + 124 + t) * 128 + kvh * 64 + d) = v; } }
                    }
                } else if (u.pn <= 4) {
#pragma unroll
                    for (int bj = 0; bj < 2; ++bj) { const f32x4 v0 = acc[ai][bj][m][0] * rs, v1 = acc[ai][bj][m][1] * rs; const int col = 256 * (u.pn - 3) + 128 * bj + 32 * wc + 8 * fq;
                        *(u32x4*)(xbc + (size_t)row * 512 + col) = (u32x4){cvt_pk_bf16(v0[0], v0[1]), cvt_pk_bf16(v0[2], v0[3]), cvt_pk_bf16(v1[0], v1[1]), cvt_pk_bf16(v1[2], v1[3])};
                        if (kind == 0 && t >= LP - 3) { float* op = out + OFF_PC + ((size_t)(l * NB + b) * 3 + (t - (LP - 3))) * 512 + col; *(f32x4*)op = v0; *(f32x4*)(op + 4) = v1; }
                        if (kind == 1 && t >= 1) { float* op = out + OFF_SC + ((size_t)(l * SB + b) * 3 + (t - 1)) * 512 + col; *(f32x4*)op = v0; *(f32x4*)(op + 4) = v1; } }
                } else {
#pragma unroll
                    for (int bj = 0; bj < 2; ++bj) { const f32x4 v0 = acc[ai][bj][m][0] * rs, v1 = acc[ai][bj][m][1] * rs; const int col = 256 * (u.pn - 5) + 128 * bj + 32 * wc + 8 * fq;
                        *(u32x4*)(G + (long)row * 512 + col + (u.pm >= 64 ? G_DELTA : 0)) = (u32x4){cvt_pk_bf16(gelu_tanh(v0[0]), gelu_tanh(v0[1])), cvt_pk_bf16(gelu_tanh(v0[2]), gelu_tanh(v0[3])), cvt_pk_bf16(gelu_tanh(v1[0]), gelu_tanh(v1[1])), cvt_pk_bf16(gelu_tanh(v1[2]), gelu_tanh(v1[3]))}; }
                }
            }
    }
};
struct EpiGU {
    static constexpr bool PERM = true, AFTER_DRAIN = false;
    const float* xss; bf16_t* hact;
    __device__ __forceinline__ void operator()(const f32x4 (&acc)[2][2][4][2], const Unit& u, int wr, int wc, int fr, int fq) const {
        float rsv[2][4];
#pragma unroll
        for (int ai = 0; ai < 2; ++ai)
#pragma unroll
            for (int m = 0; m < 4; ++m) rsv[ai][m] = row_rs(xss, u.pm * BM + ai * HALF + wr * 64 + m * 16 + fr);
#pragma unroll
        for (int ai = 0; ai < 2; ++ai)
#pragma unroll
            for (int m = 0; m < 4; ++m) {
                const int row = u.pm * BM + ai * HALF + wr * 64 + m * 16 + fr; const float rs = rsv[ai][m];
                float h[8];
#pragma unroll
                for (int n = 0; n < 2; ++n)
#pragma unroll
                    for (int j = 0; j < 4; ++j) { const float g = acc[ai][0][m][n][j] * rs, uu = acc[ai][1][m][n][j] * rs; h[4 * n + j] = g * __builtin_amdgcn_rcpf(1.f + __expf(-g)) * uu; }
                { const u32x4 hv4 = (u32x4){cvt_pk_bf16(h[0], h[1]), cvt_pk_bf16(h[2], h[3]), cvt_pk_bf16(h[4], h[5]), cvt_pk_bf16(h[6], h[7])}; bf16_t* hp = hact + (size_t)row * D_FF + 128 * u.pn + 32 * wc + 8 * fq;
                    if (u.pm >= 64) asm volatile("global_store_dwordx4 %0, %1, off sc1\n\ts_nop 1" :: "v"(hp), "v"(hv4) : "memory");
                    else *(u32x4*)hp = hv4; }
            }
    }
};
struct EpiRes {
    static constexpr bool PERM = true, AFTER_DRAIN = true;
    float* out; int final_; bf16_t* xb16; float* xss; const float* gain; unsigned* xbuf; unsigned* cnt; unsigned* ready; unsigned* gdone; const unsigned* xcc_of;
    __device__ __forceinline__ void fused(f32x4 (&acc)[2][2][4][2], const Unit& u, int wr, int wc, int fr, int fq, PG8_LAS unsigned char* lds, int wid, int lane) const {
        PG8_LAS float* P = (PG8_LAS float*)lds;
        PG8_LAS float* S = (PG8_LAS float*)(lds + 4096);
        PG8_LAS float* P2 = (PG8_LAS float*)(lds + 8192);
        const int col0 = u.pn * BM + wc * 32 + 8 * fq;
        u32x4 pre[2][4][2];
#pragma unroll
        for (int ai = 0; ai < 2; ++ai)
#pragma unroll
            for (int m = 0; m < 4; ++m) { const bf16_t* br = xb16 + (size_t)(u.pm * BM + ai * HALF + wr * 64 + m * 16 + fr) * DM + col0;
#pragma unroll
                for (int bj = 0; bj < 2; ++bj) pre[ai][m][bj] = *(const u32x4*)(br + bj * HALF); }
#pragma unroll
        for (int ai = 0; ai < 2; ++ai)
#pragma unroll
            for (int m = 0; m < 4; ++m) { float s = 0.f;
#pragma unroll
                for (int bj = 0; bj < 2; ++bj)
#pragma unroll
                    for (int n = 0; n < 2; ++n) { const f32x4 x = acc[ai][bj][m][n]; s += (x[0] * x[0] + x[1] * x[1]) + (x[2] * x[2] + x[3] * x[3]); }
                s += __shfl_xor(s, 16); s += __shfl_xor(s, 32);
                if (fq == 0) P[(ai * HALF + wr * 64 + m * 16 + fr) * 4 + wc] = s; }
        asm volatile("s_waitcnt lgkmcnt(0)" ::: "memory"); __builtin_amdgcn_s_barrier(); asm volatile("" ::: "memory");
        const int row = wid * 32 + (lane & 31);
        if (lane < 32) { const float tot = (P[row * 4 + 0] + P[row * 4 + 1]) + (P[row * 4 + 2] + P[row * 4 + 3]);
            __hip_atomic_store(xbuf + ((size_t)(u.pm * BM + row) * 4 + u.pn), __float_as_uint(tot), __ATOMIC_RELAXED, __HIP_MEMORY_SCOPE_AGENT); }
        asm volatile("s_waitcnt vmcnt(0)" ::: "memory");
        if (lane == 0) __hip_atomic_fetch_add(cnt + 64 * u.pm, 1u, __ATOMIC_RELAXED, __HIP_MEMORY_SCOPE_AGENT);
        if (wid == 0) { unsigned spins = 0;
            for (;;) { if ((unsigned)__builtin_amdgcn_readfirstlane(__hip_atomic_load(cnt + 64 * u.pm, __ATOMIC_RELAXED, __HIP_MEMORY_SCOPE_AGENT)) >= 32u) break;
                if (++spins > (1u << 22)) break; __builtin_amdgcn_s_sleep(2); } }
        asm volatile("s_waitcnt vmcnt(0) lgkmcnt(0)" ::: "memory"); __builtin_amdgcn_s_barrier(); asm volatile("" ::: "memory");
        if (lane < 32) { const unsigned* sl = xbuf + (size_t)(u.pm * BM + row) * 4; float t = 0.f;
#pragma unroll
            for (int k = 0; k < 4; ++k) t += __uint_as_float(__hip_atomic_load(sl + k, __ATOMIC_RELAXED, __HIP_MEMORY_SCOPE_AGENT));
            S[row] = rsqrtf(t * (1.0f / 1024.0f) + EPS); }
        asm volatile("s_waitcnt lgkmcnt(0)" ::: "memory"); __builtin_amdgcn_s_barrier(); asm volatile("" ::: "memory");
        f32x4 gv[2][2];
#pragma unroll
        for (int bj = 0; bj < 2; ++bj)
#pragma unroll
            for (int n = 0; n < 2; ++n) gv[bj][n] = *(const f32x4*)(gain + col0 + bj * HALF + n * 4);
#pragma unroll
        for (int ai = 0; ai < 2; ++ai)
#pragma unroll
            for (int m = 0; m < 4; ++m) { const int r = ai * HALF + wr * 64 + m * 16 + fr, grow = u.pm * BM + r; const float rstd = S[r];
                bf16_t* br = xb16 + (size_t)grow * DM; float ss = 0.f;
                float* yr = nullptr;
                if (final_) { if (grow < MP) { const int b = grow / LP, t = grow - b * LP; if (t >= NMETA) yr = out + OFF_YP + ((size_t)b * SEQ + (t - NMETA)) * DM; } else if (grow < MV) yr = out + OFF_YS + (size_t)(grow - MP) * DM; }
#pragma unroll
                for (int bj = 0; bj < 2; ++bj) { const int c = col0 + bj * HALF; const u32x4 pb = pre[ai][m][bj];
                    const f32x4 o0 = (f32x4){bflo(pb.x), bfhi(pb.x), bflo(pb.y), bfhi(pb.y)} + acc[ai][bj][m][0] * rstd * gv[bj][0], o1 = (f32x4){bflo(pb.z), bfhi(pb.z), bflo(pb.w), bfhi(pb.w)} + acc[ai][bj][m][1] * rstd * gv[bj][1];
                    if (yr) { *(f32x4*)(yr + c) = o0; *(f32x4*)(yr + c + 4) = o1; }
                    if (!final_) *(u32x4*)(br + c) = (u32x4){cvt_pk_bf16(o0[0], o0[1]), cvt_pk_bf16(o0[2], o0[3]), cvt_pk_bf16(o1[0], o1[1]), cvt_pk_bf16(o1[2], o1[3])};
                    ss += ((o0[0] * o0[0] + o0[1] * o0[1]) + (o0[2] * o0[2] + o0[3] * o0[3])) + ((o1[0] * o1[0] + o1[1] * o1[1]) + (o1[2] * o1[2] + o1[3] * o1[3])); }
                ss += __shfl_xor(ss, 16); ss += __shfl_xor(ss, 32);
                if (fq == 0) P2[r * 4 + wc] = ss; }
        if (final_) return;
        asm volatile("s_waitcnt lgkmcnt(0)" ::: "memory"); __builtin_amdgcn_s_barrier(); asm volatile("" ::: "memory");
        if (lane < 32 && !final_) xss[(size_t)(u.pm * BM + row) * 4 + u.pn] = (P2[row * 4 + 0] + P2[row * 4 + 1]) + (P2[row * 4 + 2] + P2[row * 4 + 3]);
        asm volatile("s_waitcnt vmcnt(0)" ::: "memory"); __builtin_amdgcn_s_barrier(); asm volatile("" ::: "memory");
        if (wid == 0) {
            bool flush = u.pm >= 64 && !final_;
            if (!flush && !final_) { const unsigned my = ((unsigned)__builtin_amdgcn_s_getreg((3 << 11) | 20) & 0xFu) + 1u;
                const unsigned v = lane < 32 ? __hip_atomic_load(xcc_of + 32 * (u.pm >> 3) + lane, __ATOMIC_RELAXED, __HIP_MEMORY_SCOPE_AGENT) : my;
                flush = __builtin_amdgcn_ballot_w64(v != my) != 0ull; }
            if (flush) __builtin_amdgcn_fence(__ATOMIC_RELEASE, "agent");
            asm volatile("s_waitcnt vmcnt(0)" ::: "memory");
            if (lane == 0) { if (u.pm < 64) __hip_atomic_fetch_add(gdone + 64 * ((unsigned)__builtin_amdgcn_s_getreg((3 << 11) | 20) & 0xFu), 8u, __ATOMIC_RELAXED, __HIP_MEMORY_SCOPE_AGENT); else __hip_atomic_fetch_add(ready + 64 * u.pm, 8u, __ATOMIC_RELAXED, __HIP_MEMORY_SCOPE_AGENT); } }
    }
};
__device__ __forceinline__ int tail_owner(int vcu) { const int x = vcu >> 5, j = vcu & 31; return j == 24 ? x : (j == 25 && x < 4) ? 8 + x : -1; }
struct PanelOrder {
    int vcu, round; const unsigned* gcnt;
    __device__ __forceinline__ bool next(int i, Unit& u) const { if (i > 0) return false; if (round == 0) { u.pm = vcu >> 2; u.pn = vcu & 3; return true; }
        const int tu = tail_owner(vcu); if (tu < 0) return false; u.pm = 64 + (tu >> 2); u.pn = tu & 3; return true; }
    __device__ __forceinline__ void a_ready(const Unit& u) const {
        if (gcnt) { if (threadIdx.x < 64) { unsigned polls = 0;
                for (;;) { const unsigned v = (threadIdx.x < 8) ? __hip_atomic_load(gcnt + 64 * threadIdx.x, __ATOMIC_RELAXED, __HIP_MEMORY_SCOPE_AGENT) : 32u;
                    const bool ok = (u.pm < 64) ? ((unsigned)__builtin_amdgcn_readlane((int)v, (vcu >> 5) & 7) >= 32u) : (__builtin_amdgcn_ballot_w64(v < 32u) == 0ull);
                    if (ok) break; if (++polls > (1u << 22)) break; __builtin_amdgcn_s_sleep(2); }
                __builtin_amdgcn_fence(__ATOMIC_ACQUIRE, "agent");
                asm volatile("s_waitcnt vmcnt(0)" ::: "memory"); }
            asm volatile("" ::: "memory"); __builtin_amdgcn_s_barrier(); asm volatile("" ::: "memory"); }
    }
    __device__ __forceinline__ void done(const Unit&) const {}
};
struct GatedOrder {
    int vcu, nN, skip_t; const unsigned* ready; const unsigned* gdone; unsigned need; mutable int waited;
    __device__ __forceinline__ bool next(int i, Unit& u) const {
        const int x = vcu >> 5, j = vcu & 31, nr = (nN + 3) >> 2, tu = tail_owner(vcu);
        if (skip_t == 1 && tu >= 0) return false;
        if (skip_t == 2 && tu >= 0 && i >= nr - 2) return false;
        if (i >= nr) return false;
        const int pn = 4 * i + (j >> 3);
        if (pn < nN) { u.pm = 8 * x + (j & 7); u.pn = pn; return true; }
        if (tu >= 0) return false;
        const int nfree_per = 32 - 8 * (nN & 3), f0 = 32 - nfree_per, nT = x < 4 ? 2 : 1;
        const int lidx = (j - f0) - (j > 24 ? 1 : 0) - ((x < 4 && j > 25) ? 1 : 0);
        if (skip_t && lidx < nT) { u.pm = 8 * x + lidx; u.pn = (skip_t == 2 ? 4 * (nr - 2) : 0) + 3; return true; }
        const int sk = skip_t ? 1 : 0, xm = x < 4 ? x : 4;
        const int t = x * nfree_per - (1 + sk) * (x + xm) + lidx - (skip_t ? nT : 0);
        if (t < 3 * nN) { u.pm = 64 + t / nN; u.pn = t % nN; return true; }
        return false;
    }
    __device__ __forceinline__ void a_ready(const Unit& u) const {
        if (need && (!waited || u.pm >= 64)) { waited = 1; if (threadIdx.x < 64) { unsigned polls = 0;
                for (;;) { unsigned v = (threadIdx.x < 16) ? __hip_atomic_load(gdone + 64 * threadIdx.x, __ATOMIC_RELAXED, __HIP_MEMORY_SCOPE_AGENT) : 0u;
                    v += (unsigned)__builtin_amdgcn_update_dpp(0, (int)v, 0x111, 0xf, 0xf, true); v += (unsigned)__builtin_amdgcn_update_dpp(0, (int)v, 0x112, 0xf, 0xf, true); v += (unsigned)__builtin_amdgcn_update_dpp(0, (int)v, 0x114, 0xf, 0xf, true); v += (unsigned)__builtin_amdgcn_update_dpp(0, (int)v, 0x118, 0xf, 0xf, true);
                    if ((unsigned)__builtin_amdgcn_readlane((int)v, 15) >= 2048u) break; if (++polls > (1u << 22)) break; __builtin_amdgcn_s_sleep(2); }
                if (u.pm >= 64) { while ((unsigned)__builtin_amdgcn_readfirstlane(__hip_atomic_load(ready + 64 * u.pm, __ATOMIC_RELAXED, __HIP_MEMORY_SCOPE_AGENT)) < need) { if (++polls > (1u << 22)) break; __builtin_amdgcn_s_sleep(2); } }
                __builtin_amdgcn_fence(__ATOMIC_ACQUIRE, "agent");
                asm volatile("s_waitcnt vmcnt(0)" ::: "memory"); }
            asm volatile("" ::: "memory"); __builtin_amdgcn_s_barrier(); asm volatile("" ::: "memory"); }
    }
    __device__ __forceinline__ void done(const Unit&) const {}
};
template <class Epi, class Sched, bool ALIGN_EPI = false, bool SP2 = false>
__device__ __forceinline__ void gemm_phase(PG8_LAS unsigned char* lds, const Gemm g, const Sched& S, const Epi& E) {
    int tid_ = threadIdx.x; asm volatile("" : "+v"(tid_));
    const int tid = tid_, wid = __builtin_amdgcn_readfirstlane(tid >> 6), lane = tid & 63, wr = wid >> 2, wc = wid & 3, fr = lane & 15, fq = lane >> 4;
    const int K = g.K, nt = K / BK;
    unsigned voffA[2], voffB[2];
#pragma unroll
    for (int i = 0; i < 2; ++i) { int R, C; stage_rc(tid * 16 + i * 8192, R, C); const int Rb = Epi::PERM ? ((R & ~31) + perm32(R & 31)) : R;
        voffA[i] = (unsigned)(R * K + C) * 2u; voffB[i] = (unsigned)(Rb * K + C) * 2u; }
    const size_t kstep = (size_t)(BK * 2);
    const size_t hstep = (size_t)HALF * K * 2;
    const size_t tstep = 2 * hstep;
    const unsigned ldsw = (unsigned)wid * 1024u;
    const int aoff = lds_byte(wr * 64 + fr, fq * 8), boff = lds_byte(wc * 32 + fr, fq * 8);
#define PG8_SA(b, h) (((b) * 2 + (h)) * HTB)
#define PG8_SB(b, h) ((4 + (b) * 2 + (h)) * HTB)
#define PG8_STAGE(bufoff, gbase, voff) do { _Pragma("unroll") for (int _i = 0; _i < 2; ++_i) \
        __builtin_amdgcn_global_load_lds((const unsigned*)((const char*)(gbase) + (voff)[_i]), (PG8_LAS unsigned*)(lds + (bufoff) + ldsw + _i * 8192), 16, 0, 0); } while (0)
#define PG8_LDA(dst, b, h) do { _Pragma("unroll") for (int m = 0; m < 4; ++m) _Pragma("unroll") for (int k = 0; k < 2; ++k) dst[m][k] = *(const PG8_LAS bf16x8*)(lds + PG8_SA(b, h) + aoff + m * 2048 + k * 1024); } while (0)
#define PG8_LDB(dst, b, h) do { _Pragma("unroll") for (int n = 0; n < 2; ++n) _Pragma("unroll") for (int k = 0; k < 2; ++k) dst[n][k] = *(const PG8_LAS bf16x8*)(lds + PG8_SB(b, h) + boff + n * 2048 + k * 1024); } while (0)
#define PG8_MMA(ai, bj, At, Bt) do { __builtin_amdgcn_s_setprio(1); _Pragma("unroll") for (int m = 0; m < 4; ++m) _Pragma("unroll") for (int n = 0; n < 2; ++n) _Pragma("unroll") for (int k = 0; k < 2; ++k) \
        acc[ai][bj][m][n] = __builtin_amdgcn_mfma_f32_16x16x32_bf16(Bt[n][k], At[m][k], acc[ai][bj][m][n], 0, 0, 0); __builtin_amdgcn_s_setprio(0); } while (0)
#define PG8_WAIT_V(n) asm volatile("s_waitcnt vmcnt(" #n ")" ::: "memory")
#define PG8_WAIT_L(n) asm volatile("s_waitcnt lgkmcnt(" #n ")" ::: "memory")
#define PG8_BAR __builtin_amdgcn_s_barrier()
#define PG8_SCHED __builtin_amdgcn_sched_barrier(0)
    Unit cur, nxt; int ui = 0;
    if (!S.next(0, cur)) return;
    f32x4 acc[2][2][4][2];
#pragma unroll
    for (int a = 0; a < 2; ++a)
#pragma unroll
        for (int b = 0; b < 2; ++b)
#pragma unroll
            for (int m = 0; m < 4; ++m)
#pragma unroll
                for (int n = 0; n < 2; ++n) acc[a][b][m][n] = (f32x4){0.f, 0.f, 0.f, 0.f};
    bf16x8 At[4][2], B0[2][2], B1[2][2];
    const char* cA = (const char*)g.A + (size_t)cur.pm * tstep; const char* cB = (const char*)g.Bt + (size_t)cur.pn * tstep;
    S.a_ready(cur);
    if constexpr (SP2) {
        PG8_STAGE(PG8_SB(0, 0), cB, voffB); PG8_STAGE(PG8_SB(0, 1), cB + hstep, voffB); PG8_STAGE(PG8_SA(0, 0), cA, voffA); PG8_STAGE(PG8_SA(0, 1), cA + hstep, voffA);
        if (wr == 1) PG8_BAR;
        PG8_WAIT_V(2); PG8_BAR;
        PG8_STAGE(PG8_SB(1, 0), cB + kstep, voffB); PG8_STAGE(PG8_SA(1, 0), cA + kstep, voffA); PG8_STAGE(PG8_SB(1, 1), cB + hstep + kstep, voffB);
        PG8_WAIT_V(6); PG8_BAR;
    } else {
        PG8_STAGE(PG8_SB(0, 0), cB, voffB); PG8_STAGE(PG8_SA(0, 0), cA, voffA); PG8_STAGE(PG8_SB(0, 1), cB + hstep, voffB); PG8_STAGE(PG8_SA(0, 1), cA + hstep, voffA);
        if (wr == 1) PG8_BAR;
        PG8_WAIT_V(4); PG8_BAR;
        PG8_STAGE(PG8_SB(1, 0), cB + kstep, voffB); PG8_STAGE(PG8_SA(1, 0), cA + kstep, voffA); PG8_STAGE(PG8_SB(1, 1), cB + hstep + kstep, voffB);
        PG8_WAIT_V(6); PG8_BAR;
    }
    for (;;) {
        const bool has_next = S.next(ui + 1, nxt);
        const char* nA = has_next ? (const char*)g.A + (size_t)nxt.pm * tstep : cA; const char* nB = has_next ? (const char*)g.Bt + (size_t)nxt.pn * tstep : cB;
        for (int t = 0; t < nt; t += 2) {
            const bool last = (t == nt - 2);
            const char* a1 = cA + (size_t)(t + 1) * kstep;
            const char* a2 = last ? nA : cA + (size_t)(t + 2) * kstep; const char* b2 = last ? nB : cB + (size_t)(t + 2) * kstep;
            const char* a3 = a2 + kstep; const char* b3 = b2 + kstep;
            if (last && has_next) S.a_ready(nxt);
            if constexpr (SP2) {
            PG8_LDB(B0, 0, 0); PG8_LDB(B1, 0, 1); PG8_SCHED; PG8_LDA(At, 0, 0); PG8_STAGE(PG8_SA(1, 1), a1 + hstep, voffA);
            PG8_WAIT_V(8); PG8_WAIT_L(0); PG8_BAR; PG8_MMA(0, 0, At, B0); PG8_MMA(0, 1, At, B1); PG8_BAR; PG8_SCHED;
            PG8_LDA(At, 0, 1); PG8_STAGE(PG8_SB(0, 0), b2, voffB); PG8_STAGE(PG8_SB(0, 1), b2 + hstep, voffB); PG8_STAGE(PG8_SA(0, 0), a2, voffA);
            PG8_WAIT_V(8); PG8_WAIT_L(0); PG8_BAR; PG8_MMA(1, 0, At, B0); PG8_MMA(1, 1, At, B1); PG8_BAR; PG8_SCHED;
            PG8_LDB(B0, 1, 0); PG8_LDB(B1, 1, 1); PG8_SCHED; PG8_LDA(At, 1, 0); PG8_STAGE(PG8_SA(0, 1), a2 + hstep, voffA);
            PG8_WAIT_V(8); PG8_WAIT_L(0); PG8_BAR; PG8_MMA(0, 0, At, B0); PG8_MMA(0, 1, At, B1); PG8_BAR; PG8_SCHED;
            PG8_LDA(At, 1, 1); PG8_STAGE(PG8_SB(1, 0), b3, voffB); PG8_STAGE(PG8_SB(1, 1), b3 + hstep, voffB); PG8_STAGE(PG8_SA(1, 0), a3, voffA);
            PG8_WAIT_V(8); PG8_WAIT_L(0); PG8_BAR; PG8_MMA(1, 0, At, B0); PG8_MMA(1, 1, At, B1); PG8_BAR; PG8_SCHED;
            } else {
            PG8_LDB(B0, 0, 0); PG8_SCHED; PG8_LDA(At, 0, 0); PG8_STAGE(PG8_SA(1, 1), a1 + hstep, voffA);
            PG8_WAIT_L(8); PG8_BAR; PG8_WAIT_L(0); PG8_MMA(0, 0, At, B0); PG8_BAR; PG8_SCHED;
            PG8_LDB(B1, 0, 1); PG8_STAGE(PG8_SB(0, 0), b2, voffB);
            PG8_BAR; PG8_WAIT_L(0); PG8_MMA(0, 1, At, B1); PG8_BAR;
            PG8_LDA(At, 0, 1); PG8_STAGE(PG8_SA(0, 0), a2, voffA);
            PG8_BAR; PG8_WAIT_L(0); PG8_MMA(1, 0, At, B0); PG8_BAR; PG8_SCHED;
            PG8_STAGE(PG8_SB(0, 1), b2 + hstep, voffB);
            PG8_WAIT_V(6); PG8_BAR; PG8_MMA(1, 1, At, B1); PG8_BAR;
            PG8_LDB(B0, 1, 0); PG8_SCHED; PG8_LDA(At, 1, 0); PG8_STAGE(PG8_SA(0, 1), a2 + hstep, voffA);
            PG8_WAIT_L(8); PG8_BAR; PG8_WAIT_L(0); PG8_MMA(0, 0, At, B0); PG8_BAR; PG8_SCHED;
            PG8_LDB(B1, 1, 1); PG8_STAGE(PG8_SB(1, 0), b3, voffB);
            PG8_BAR; PG8_WAIT_L(0); PG8_MMA(0, 1, At, B1); PG8_BAR;
            PG8_LDA(At, 1, 1); PG8_STAGE(PG8_SA(1, 0), a3, voffA);
            PG8_BAR; PG8_WAIT_L(0); PG8_MMA(1, 0, At, B0); PG8_BAR; PG8_SCHED;
            PG8_STAGE(PG8_SB(1, 1), b3 + hstep, voffB);
            PG8_WAIT_V(6); PG8_BAR; PG8_MMA(1, 1, At, B1); PG8_BAR;
            }
        }
        if constexpr (ALIGN_EPI) { if (wr == 0) PG8_BAR; }
        if constexpr (!Epi::AFTER_DRAIN) { E(acc, cur, wr, wc, fr, fq); S.done(cur); }
        if (!has_next) break;
#pragma unroll
        for (int a = 0; a < 2; ++a)
#pragma unroll
            for (int b = 0; b < 2; ++b)
#pragma unroll
                for (int m = 0; m < 4; ++m)
#pragma unroll
                    for (int n = 0; n < 2; ++n) acc[a][b][m][n] = (f32x4){0.f, 0.f, 0.f, 0.f};
        cur = nxt; cA = nA; cB = nB; ++ui;
        if constexpr (ALIGN_EPI) { if (wr == 1) PG8_BAR; }
    }
    PG8_WAIT_V(0);
    if constexpr (!ALIGN_EPI) { if (wr == 0) PG8_BAR; }
    PG8_BAR;
    if constexpr (Epi::AFTER_DRAIN) { E.fused(acc, cur, wr, wc, fr, fq, lds, wid, lane); S.done(cur); }
#undef PG8_SA
#undef PG8_SB
#undef PG8_STAGE
#undef PG8_LDA
#undef PG8_LDB
#undef PG8_MMA
#undef PG8_WAIT_V
#undef PG8_WAIT_L
#undef PG8_BAR
#undef PG8_SCHED
}
}
constexpr int NWAVES = 8, NTHREADS = 512, LDS_BYTES = 131072 + 20480;
struct Args { const float* in[26]; float* out; unsigned char* ws; };
struct Ctx {
    unsigned char* lds;
    int tid, lane, wave, vcu, gw;
};
#define OPQ_PTRS unsigned long long ws_i_ = (unsigned long long)A.ws, out_i_ = (unsigned long long)A.out; asm volatile("" : "+s"(ws_i_), "+s"(out_i_)); unsigned char* ws = (unsigned char*)(__attribute__((address_space(1))) unsigned char*)ws_i_; float* out = (float*)(__attribute__((address_space(1))) float*)out_i_
#define IN_XP 0
#define IN_XS 1
#define IN_CK 2
#define IN_CV 3
#define IN_SH 4
#define IN_SC 5
#define IN_META 6
#define IN_PREMIX 7
#define IN_WIN 8
#define IN_SINK 9
#define IN_CONVW 10
#define IN_CONVB 11
#define IN_WA 12
#define IN_BA 13
#define IN_WI 14
#define IN_BI 15
#define IN_LAM 16
#define IN_ATTN_G 17
#define IN_LRU_G 18
#define IN_WOUT 19
#define IN_POSTMIX 20
#define IN_PREFFN 21
#define IN_WGATE 22
#define IN_WUP 23
#define IN_WDOWN 24
#define IN_POSTFFN 25

__device__ __forceinline__ int dest_row(int mode, int c) {
    if (mode == 1) { if (c >= 640) return c; const int d = c & 63, n = d >> 5, w = (d >> 4) & 1, fq = (d >> 2) & 3, j = d & 3; return (c & ~63) + 32 * w + 8 * fq + 4 * n + j; }
    if (mode == 2) return 256 * (c >> 7) + (c & 127);
    if (mode == 3) return 256 * (c >> 7) + 128 + (c & 127);
    return c;
}
__device__ __forceinline__ void transpose_item(const float* W, int K, int N, bf16_t* WT, int mode, const float* g1, const float* g2, float* scr, int item, int lane) {
    const int nblk = N / 32, kb = item / nblk, nb = item % nblk, k0 = 64 * kb, n0 = 32 * nb;
    float wv[32];
#pragma unroll
    for (int i = 0; i < 32; ++i) { const int kk = 2 * i + (lane >> 5); wv[i] = W[(size_t)(k0 + kk) * N + n0 + (lane & 31)]; }
    if (g1) {
#pragma unroll
        for (int i = 0; i < 32; ++i) { const int k = k0 + 2 * i + (lane >> 5); wv[i] *= (k < 512 || !g2) ? g1[k] : g2[k - 512]; } }
#pragma unroll
    for (int i = 0; i < 32; ++i) { const int kk = 2 * i + (lane >> 5); scr[kk * 33 + (lane & 31)] = wv[i]; }
    asm volatile("s_waitcnt lgkmcnt(0)" ::: "memory");
    const int c = lane & 7;
#pragma unroll
    for (int j = 0; j < 4; ++j) { const int n = (lane >> 3) + 8 * j; const float* s = scr + (8 * c) * 33 + n;
        u32x4 o; o.x = cvt_pk_bf16(s[0 * 33], s[1 * 33]); o.y = cvt_pk_bf16(s[2 * 33], s[3 * 33]); o.z = cvt_pk_bf16(s[4 * 33], s[5 * 33]); o.w = cvt_pk_bf16(s[6 * 33], s[7 * 33]);
        *(u32x4*)(WT + (size_t)dest_row(mode, n0 + n) * K + k0 + 8 * c) = o; }
    asm volatile("s_waitcnt lgkmcnt(0)" ::: "memory");
}
__device__ __forceinline__ void p0_prologue(const Args& A, Ctx& C) {
    OPQ_PTRS;
    float* scr = (float*)(C.lds + C.wave * 8448);
    const int NGW = 256 * NWAVES;
    constexpr int I_IN = 16 * 56, I_OUT = 16 * 32, I_G = 16 * 88, I_D = 44 * 32, I_LAYER = I_IN + I_OUT + 2 * I_G + I_D;
    for (int it = C.gw; it < DEPTH * I_LAYER; it += NGW) {
        const int l = it / I_LAYER; int r = it - l * I_LAYER;
        unsigned char* wb = ws + WS_W + (size_t)l * W_LAYER_B;
        if (r < I_IN) { transpose_item(A.in[IN_WIN] + (size_t)l * DM * IN_W, DM, IN_W, (bf16_t*)wb, 1, A.in[IN_PREMIX] + l * DM, nullptr, scr, r, C.lane); continue; } r -= I_IN;
        if (r < I_OUT) { transpose_item(A.in[IN_WOUT] + (size_t)l * DM * DM, DM, DM, (bf16_t*)(wb + W_IN_B), 0, A.in[IN_ATTN_G] + l * 512, A.in[IN_LRU_G] + l * 512, scr, r, C.lane); continue; } r -= I_OUT;
        if (r < I_G) { transpose_item(A.in[IN_WGATE] + (size_t)l * DM * D_FF, DM, D_FF, (bf16_t*)(wb + W_IN_B + W_OUT_B), 2, A.in[IN_PREFFN] + l * DM, nullptr, scr, r, C.lane); continue; } r -= I_G;
        if (r < I_G) { transpose_item(A.in[IN_WUP] + (size_t)l * DM * D_FF, DM, D_FF, (bf16_t*)(wb + W_IN_B + W_OUT_B), 3, A.in[IN_PREFFN] + l * DM, nullptr, scr, r, C.lane); continue; } r -= I_G;
        transpose_item(A.in[IN_WDOWN] + (size_t)l * D_FF * DM, D_FF, DM, (bf16_t*)(wb + W_IN_B + W_OUT_B + W_GU_B), 0, nullptr, nullptr, scr, r, C.lane);
    }
    float* xmeta = (float*)(ws + WS_XMETA); bf16_t* xb16 = (bf16_t*)(ws + WS_XB16); float* xss = (float*)(ws + WS_XSS);
    for (int row0 = C.gw; row0 < MPAD; row0 += 4 * NGW) {
        f32x4 v[4][4]; bool ok[4];
#pragma unroll
        for (int q = 0; q < 4; ++q) { const int row = row0 + q * NGW; ok[q] = row < MPAD; const float* src = nullptr;
            if (row < MP) { const int b = row / LP, t = row - b * LP; src = t < NMETA ? A.in[IN_META] + (size_t)t * DM : A.in[IN_XP] + ((size_t)b * SEQ + (t - NMETA)) * DM; }
            else if (row < MV) src = A.in[IN_XS] + (size_t)(row - MP) * DM;
#pragma unroll
            for (int j = 0; j < 4; ++j) v[q][j] = src ? *((const f32x4*)src + C.lane + 64 * j) : (f32x4){0.f, 0.f, 0.f, 0.f}; }
        float sq[4];
#pragma unroll
        for (int q = 0; q < 4; ++q) { sq[q] = 0.f;
#pragma unroll
            for (int j = 0; j < 4; ++j) { const f32x4 x = v[q][j]; sq[q] += (x[0] * x[0] + x[1] * x[1]) + (x[2] * x[2] + x[3] * x[3]); } }
#pragma unroll
        for (int o = 1; o < 64; o <<= 1) {
#pragma unroll
            for (int q = 0; q < 4; ++q) sq[q] += __shfl_xor(sq[q], o); }
#pragma unroll
        for (int q = 0; q < 4; ++q) { if (!ok[q]) continue; const int row = row0 + q * NGW;
#pragma unroll
            for (int j = 0; j < 4; ++j) *((u32x2*)(xb16 + (size_t)row * DM) + C.lane + 64 * j) = (u32x2){cvt_pk_bf16(v[q][j][0], v[q][j][1]), cvt_pk_bf16(v[q][j][2], v[q][j][3])};
            if (C.lane < 4) xss[(size_t)row * 4 + C.lane] = C.lane == 0 ? sq[q] : 0.f; }
    }
    bf16_t* kS = (bf16_t*)(ws + WS_KS); bf16_t* vTS = (bf16_t*)(ws + WS_VTS);
    bf16_t* vl = (bf16_t*)C.lds;
    for (int lb = C.vcu; lb < DEPTH * SB; lb += 256) {
        __syncthreads();
        const f32x4* ksrc = (const f32x4*)(A.in[IN_CK] + (size_t)lb * 16384); const f32x4* vsrc = (const f32x4*)(A.in[IN_CV] + (size_t)lb * 16384);
        f32x4 kv[8], vv[8];
#pragma unroll
        for (int i = 0; i < 8; ++i) { kv[i] = ksrc[i * 512 + C.tid]; vv[i] = vsrc[i * 512 + C.tid]; }
#pragma unroll
        for (int i = 0; i < 8; ++i) { const int idx = i * 512 + C.tid, j = idx >> 5, c4 = (idx & 31) * 4;
            *(u32x2*)(kS + ((size_t)lb * KS_ROWS + j) * 128 + c4) = (u32x2){cvt_pk_bf16(kv[i][0], kv[i][1]), cvt_pk_bf16(kv[i][2], kv[i][3])};
            const unsigned w0 = cvt_pk_bf16(vv[i][0], vv[i][1]), w1 = cvt_pk_bf16(vv[i][2], vv[i][3]);
            vl[(c4 + 0) * 136 + j] = (bf16_t)(w0 & 0xffffu); vl[(c4 + 1) * 136 + j] = (bf16_t)(w0 >> 16); vl[(c4 + 2) * 136 + j] = (bf16_t)(w1 & 0xffffu); vl[(c4 + 3) * 136 + j] = (bf16_t)(w1 >> 16);
            if (j >= 4) { *(f32x4*)(out + OFF_SK + ((size_t)lb * 128 + j - 4) * 128 + c4) = kv[i]; *(f32x4*)(out + OFF_SV + ((size_t)lb * 128 + j - 4) * 128 + c4) = vv[i]; } }
        __syncthreads();
#pragma unroll
        for (int i = 0; i < 4; ++i) { const int idx = i * 512 + C.tid, c = idx >> 4, j8 = (idx & 15) * 8;
            *(u32x4*)(vTS + ((size_t)lb * 128 + c) * VTS_LD + j8) = *(const u32x4*)(vl + c * 136 + j8); }
    }
    __syncthreads();
    bf16_t* lw = (bf16_t*)(ws + WS_LRUW);
    for (int e = C.gw * 64 + C.lane; e < DEPTH * 8 * 4096; e += NGW * 64) {
        const int i = e & 63, j = (e >> 6) & 63, lh = e >> 12;
        lw[e] = (bf16_t)(cvt_pk_bf16(A.in[IN_WA][(size_t)lh * 4096 + i * 64 + j], 0.f) & 0xffffu);
        lw[DEPTH * 8 * 4096 + e] = (bf16_t)(cvt_pk_bf16(A.in[IN_WI][(size_t)lh * 4096 + i * 64 + j], 0.f) & 0xffffu);
    }
}
#define XB_TMO      128
#define XB_XCNT(j)  (256  + 64 * (j))
#define XB_XSUB(j)  (1280 + 64 * (j))
#define XB_XGEN(j)  (2304 + 64 * (j))
#define XB_TOP      3328
#define XB_TOPGEN   3392
#define XCD_BAR_WORDS 3456
#define XB_SPIN_CAP (1u << 18)

__device__ __forceinline__ unsigned xb_ld(unsigned* p)              { return __hip_atomic_load(p, __ATOMIC_RELAXED, __HIP_MEMORY_SCOPE_AGENT); }
__device__ __forceinline__ unsigned xb_add(unsigned* p, unsigned v) { return __hip_atomic_fetch_add(p, v, __ATOMIC_RELAXED, __HIP_MEMORY_SCOPE_AGENT); }
__device__ __forceinline__ unsigned xb_xcc_id() { return (unsigned)__builtin_amdgcn_s_getreg((3 << 11) | 20) & 0xFu; }
#define XB_SPIN(cond, bar) do { unsigned _sp = 0; while (cond) { __builtin_amdgcn_s_sleep(1); \
    if ((++_sp & 255u) == 0u) { if (xb_ld(&(bar)[XB_TMO])) break; if (_sp > XB_SPIN_CAP) { atomicAdd(&(bar)[XB_TMO], 1u); break; } } } } while (0)

struct XcdBarrier {
    unsigned* bar; unsigned x;
    volatile __attribute__((address_space(3))) unsigned* st;
};

__device__ __forceinline__ XcdBarrier xcd_barrier_post(unsigned* bar, volatile __attribute__((address_space(3))) unsigned* st) {
    XcdBarrier b; b.bar = bar; b.x = xb_xcc_id(); b.st = st;
    if (threadIdx.x == 0) (void)xb_add(&bar[XB_XCNT(b.x)], 1u);
    return b;
}
__device__ __forceinline__ void xcd_barrier_complete(unsigned* bar, unsigned x, unsigned& nloc, unsigned& nx) {
    const unsigned G = gridDim.x * gridDim.y * gridDim.z;
    unsigned sum, cnt, mine, sp = 0u;
    for (;;) {
        sum = 0u; cnt = 0u; mine = 0u;
#pragma unroll
        for (unsigned j = 0; j < 16; ++j) { const unsigned c = xb_ld(&bar[XB_XCNT(j)]); sum += c; cnt += (c > 0u) ? 1u : 0u; mine = (j == x) ? c : mine; }
        if (sum == G) break;
        __builtin_amdgcn_s_sleep(1);
        if ((++sp & 255u) == 0u) { if (xb_ld(&bar[XB_TMO])) break; if (sp > XB_SPIN_CAP) { atomicAdd(&bar[XB_TMO], 1u); break; } }
    }
    nloc = mine > 0u ? mine : 1u; nx = cnt > 0u ? cnt : 1u;
}

__device__ __forceinline__ void xcd_barrier(const XcdBarrier& b) {
    asm volatile("s_waitcnt vmcnt(0)" ::: "memory");
    __syncthreads();
    if (threadIdx.x == 0) {
        unsigned* bar = b.bar;
        __builtin_amdgcn_s_waitcnt(0);
        unsigned nloc = b.st[0], nx = b.st[1];
        if (nloc == 0u) { xcd_barrier_complete(bar, b.x, nloc, nx); b.st[0] = nloc; b.st[1] = nx; }
        const unsigned old = xb_add(&bar[XB_XSUB(b.x)], 1u);
        const unsigned gen = old / nloc;
        if (old + 1u == (gen + 1u) * nloc) {
            __builtin_amdgcn_fence(__ATOMIC_RELEASE, "agent");
            asm volatile("s_waitcnt vmcnt(0)" ::: "memory");
            const unsigned og = xb_add(&bar[XB_TOP], 1u);
            const unsigned tg = og / nx;
            if (og + 1u == (tg + 1u) * nx) xb_add(&bar[XB_TOPGEN], 1u);
            else XB_SPIN(xb_ld(&bar[XB_TOPGEN]) == tg, bar);
            __builtin_amdgcn_fence(__ATOMIC_ACQUIRE, "agent");
            xb_add(&bar[XB_XGEN(b.x)], 1u);
            asm volatile("s_waitcnt vmcnt(0)" ::: "memory");
        } else {
            XB_SPIN(xb_ld(&bar[XB_XGEN(b.x)]) == gen, bar);
            __builtin_amdgcn_fence(__ATOMIC_ACQUIRE, "agent");
            asm volatile("s_waitcnt vmcnt(0)" ::: "memory");
        }
    }
    __syncthreads();
}
__device__ __forceinline__ void attn_item(const Args& A, Ctx& C, unsigned char* ws, float* out, int l, int it) {
    const int lane = C.lane, n = lane & 15, kq = lane >> 4;
    const bf16_t* Q = (const bf16_t*)(ws + WS_Q); bf16_t* O = (bf16_t*)(ws + WS_MRG);
    int tq, head, qrow, kt_hi, kstride_v; const bf16_t* Kb; const bf16_t* Vb;
    if (it < NB * 129 * 8) { const int h = it & 7, qt = (it >> 3) % 129, b = (it >> 3) / 129; tq = 16 * qt + n; head = h; qrow = b * LP + tq; kt_hi = qt;
        Kb = (const bf16_t*)(ws + WS_KP) + (size_t)b * LP * 128 + (h >> 2) * 64; Vb = (const bf16_t*)(ws + WS_VTP) + (size_t)(b * 2 + (h >> 2)) * 64 * VTP_LD; kstride_v = VTP_LD; }
    else { const int i2 = it - NB * 129 * 8, g = i2 & 1, bs = i2 >> 1; tq = 128 + (n & 3); head = 4 * g + (n >> 2); qrow = MP + bs * 4 + (n & 3); kt_hi = 8;
        Kb = (const bf16_t*)(ws + WS_KS) + (size_t)(l * SB + bs) * KS_ROWS * 128 + g * 64; Vb = (const bf16_t*)(ws + WS_VTS) + (size_t)((l * SB + bs) * 2 + g) * 64 * VTS_LD; kstride_v = VTS_LD; }
    const bf16x8 q0 = *(const bf16x8*)(Q + (size_t)qrow * 512 + head * 64 + 8 * kq), q1 = *(const bf16x8*)(Q + (size_t)qrow * 512 + head * 64 + 32 + 8 * kq);
    const float sink = A.in[IN_SINK][l * 8 + head];
    u32x2 vfa[5][4], vfb[5][4];
#pragma unroll
    for (int pr = 0; pr < 5; ++pr) { int kta = kt_hi - 8 + 2 * pr - 1, ktb = kt_hi - 8 + 2 * pr; kta = kta < 0 ? 0 : kta; ktb = ktb < 0 ? 0 : ktb;
#pragma unroll
        for (int dt = 0; dt < 4; ++dt) { const bf16_t* vp = Vb + (size_t)(16 * dt + n) * kstride_v + 4 * kq; vfa[pr][dt] = *(const u32x2*)(vp + 16 * kta); vfb[pr][dt] = *(const u32x2*)(vp + 16 * ktb); } }
    f32x4 s[9]; float mx = sink;
#pragma unroll
    for (int T = 0; T < 9; ++T) { const int kt = kt_hi - 8 + T; s[T] = (f32x4){0.f, 0.f, 0.f, 0.f};
        if (kt >= 0) { const bf16_t* kp = Kb + (size_t)(16 * kt + n) * 128 + 8 * kq; const bf16x8 k0 = *(const bf16x8*)kp, k1 = *(const bf16x8*)(kp + 32);
            s[T] = __builtin_amdgcn_mfma_f32_16x16x32_bf16(k0, q0, s[T], 0, 0, 0); s[T] = __builtin_amdgcn_mfma_f32_16x16x32_bf16(k1, q1, s[T], 0, 0, 0); }
#pragma unroll
        for (int j = 0; j < 4; ++j) { const int key = 16 * kt + 4 * kq + j; const bool ok = (key >= 0) && (key <= tq) && (key > tq - 128); s[T][j] = ok ? s[T][j] : -INFINITY; mx = fmaxf(mx, s[T][j]); } }
    mx = fmaxf(mx, __shfl_xor(mx, 16)); mx = fmaxf(mx, __shfl_xor(mx, 32));
    float sum = 0.f; u32x2 pk[9];
#pragma unroll
    for (int T = 0; T < 9; ++T) { float p[4];
#pragma unroll
        for (int j = 0; j < 4; ++j) { p[j] = __expf(s[T][j] - mx); sum += p[j]; }
        pk[T] = (u32x2){cvt_pk_bf16(p[0], p[1]), cvt_pk_bf16(p[2], p[3])}; }
    sum += __shfl_xor(sum, 16); sum += __shfl_xor(sum, 32);
    sum += __expf(sink - mx);
    const float rl = __builtin_amdgcn_rcpf(sum);
    f32x4 o[4];
#pragma unroll
    for (int dt = 0; dt < 4; ++dt) o[dt] = (f32x4){0.f, 0.f, 0.f, 0.f};
#pragma unroll
    for (int pr = 0; pr < 5; ++pr) { const int Ta = 2 * pr - 1, Tb = 2 * pr;
        const u32x2 pa = Ta >= 0 ? pk[Ta < 0 ? 0 : Ta] : (u32x2){0u, 0u}, pb = pk[Tb];
        const bf16x8 pf = __builtin_bit_cast(bf16x8, (u32x4){pa.x, pa.y, pb.x, pb.y});
#pragma unroll
        for (int dt = 0; dt < 4; ++dt) { const bf16x8 vf = __builtin_bit_cast(bf16x8, (u32x4){vfa[pr][dt].x, vfa[pr][dt].y, vfb[pr][dt].x, vfb[pr][dt].y});
            o[dt] = __builtin_amdgcn_mfma_f32_16x16x32_bf16(vf, pf, o[dt], 0, 0, 0); } }
#pragma unroll
    for (int dt = 0; dt < 4; ++dt) *(u32x2*)(O + (size_t)qrow * DM + head * 64 + 16 * dt + 4 * kq) = (u32x2){cvt_pk_bf16(o[dt][0] * rl, o[dt][1] * rl), cvt_pk_bf16(o[dt][2] * rl, o[dt][3] * rl)};
}
__device__ __forceinline__ void lru_item(const Args& A, Ctx& C, unsigned char* ws, float* out, int l, int it, const unsigned char* wl, const float* cwl) {
    const int lane = C.lane, fr = lane & 15, kq = lane >> 4;
    const bool samp = it >= NB * NCH * 8;
    int blk, b, c, rowbase;
    if (it < 2048) { blk = it & 7; c = (it >> 3) & 31; b = it >> 8; rowbase = b * LP + 64 * c; }
    else if (!samp) { blk = it & 7; c = NCH - 1; b = (it - 2048) >> 3; rowbase = b * LP + 64 * c; }
    else { const int i2 = it - NB * NCH * 8; blk = i2 & 7; c = i2 >> 3; b = 0; rowbase = MP + 16 * c; }
    const bf16_t* XBC = (const bf16_t*)(ws + WS_XBC); bf16_t* MRG = (bf16_t*)(ws + WS_MRG); bf16_t* PL = (bf16_t*)(ws + WS_PL);
    float ba[4], bi[4], lsl[4], h0v[4];
#pragma unroll
    for (int nt = 0; nt < 4; ++nt) { ba[nt] = cwl[320 + 16 * nt + fr]; bi[nt] = cwl[384 + 16 * nt + fr]; lsl[nt] = cwl[448 + 16 * nt + fr];
        h0v[nt] = samp ? A.in[IN_SH][(size_t)(l * SB + 4 * c + kq) * 512 + 64 * blk + 16 * nt + fr] : 0.f; }
    const float* cw = cwl; const float* cb = cwl + 256;
    float Pc[4], Hc[4];
#pragma unroll
    for (int nt = 0; nt < 4; ++nt) { Pc[nt] = 1.f; Hc[nt] = 0.f; }
    const int nvalid = samp ? 16 : (LP - 64 * c < 64 ? LP - 64 * c : 64);
    u32x4 xcur[2], xprev[2], xnext[2];
#pragma unroll
    for (int ks = 0; ks < 2; ++ks) { xcur[ks] = xprev[ks] = xnext[ks] = (u32x4){0u, 0u, 0u, 0u}; }
    if (!samp) {
#pragma unroll
        for (int ks = 0; ks < 2; ++ks) { const int tp = 64 * c - 16 + fr; if (tp >= 0) xprev[ks] = *(const u32x4*)(XBC + (size_t)(b * LP + tp) * 512 + 64 * blk + 32 * ks + 8 * kq);
            const int t = 64 * c + fr; if (t < LP) xcur[ks] = *(const u32x4*)(XBC + (size_t)(b * LP + t) * 512 + 64 * blk + 32 * ks + 8 * kq); }
    }
#pragma unroll 1
    for (int m = 0; m < 4; ++m) {
        if (16 * m >= nvalid) break;
        if (!samp) {
#pragma unroll
            for (int ks = 0; ks < 2; ++ks) { const int t = 64 * c + 16 * (m + 1) + fr; xnext[ks] = (m < 3 && t < LP) ? *(const u32x4*)(XBC + (size_t)(b * LP + t) * 512 + 64 * blk + 32 * ks + 8 * kq) : (u32x4){0u, 0u, 0u, 0u}; }
        }
        const int ra = 16 * m + fr; bf16x8 ua[2];
#pragma unroll
        for (int ks = 0; ks < 2; ++ks) { const int ch0 = 32 * ks + 8 * kq; float uv[8];
            { const f32x4 b0 = *(const f32x4*)(cb + ch0), b1 = *(const f32x4*)(cb + ch0 + 4); uv[0] = b0[0]; uv[1] = b0[1]; uv[2] = b0[2]; uv[3] = b0[3]; uv[4] = b1[0]; uv[5] = b1[1]; uv[6] = b1[2]; uv[7] = b1[3]; }
            if (!samp) {
                const u32x4 cur = xcur[ks], prv = xprev[ks];
#pragma unroll
                for (int sft = 0; sft < 4; ++sft) { const int j = 3 - sft; const f32x4 w0 = *(const f32x4*)(cw + j * 64 + ch0), w1 = *(const f32x4*)(cw + j * 64 + ch0 + 4); u32x4 v = cur;
                    if (sft > 0) {
#pragma unroll
                        for (int d = 0; d < 4; ++d) { const int cr = sft == 1 ? __builtin_amdgcn_update_dpp(0, (int)cur[d], 0x121, 0xf, 0xf, false) : sft == 2 ? __builtin_amdgcn_update_dpp(0, (int)cur[d], 0x122, 0xf, 0xf, false) : __builtin_amdgcn_update_dpp(0, (int)cur[d], 0x123, 0xf, 0xf, false);
                            const int pr = sft == 1 ? __builtin_amdgcn_update_dpp(0, (int)prv[d], 0x121, 0xf, 0xf, false) : sft == 2 ? __builtin_amdgcn_update_dpp(0, (int)prv[d], 0x122, 0xf, 0xf, false) : __builtin_amdgcn_update_dpp(0, (int)prv[d], 0x123, 0xf, 0xf, false);
                            v[d] = (unsigned)(fr >= sft ? cr : pr); } }
                    uv[0] += bflo(v.x) * w0[0]; uv[1] += bfhi(v.x) * w0[1]; uv[2] += bflo(v.y) * w0[2]; uv[3] += bfhi(v.y) * w0[3]; uv[4] += bflo(v.z) * w1[0]; uv[5] += bfhi(v.z) * w1[1]; uv[6] += bflo(v.w) * w1[2]; uv[7] += bfhi(v.w) * w1[3]; }
            } else {
#pragma unroll
                for (int j = 0; j < 4; ++j) { const f32x4 w0 = *(const f32x4*)(cw + j * 64 + ch0), w1 = *(const f32x4*)(cw + j * 64 + ch0 + 4); float xv[8];
                    const int sr = 16 * c + ra, bs = sr >> 2, tau = (sr & 3) + j - 3;
                    if (tau >= 0) { const u32x4 r = *(const u32x4*)(XBC + (size_t)(MP + bs * 4 + tau) * 512 + 64 * blk + ch0);
                        xv[0] = bflo(r.x); xv[1] = bfhi(r.x); xv[2] = bflo(r.y); xv[3] = bfhi(r.y); xv[4] = bflo(r.z); xv[5] = bfhi(r.z); xv[6] = bflo(r.w); xv[7] = bfhi(r.w); }
                    else { const float* sp = A.in[IN_SC] + ((size_t)(l * SB + bs) * 3 + (tau + 3)) * 512 + 64 * blk + ch0; const f32x4 r0 = *(const f32x4*)sp, r1 = *(const f32x4*)(sp + 4);
                        xv[0] = r0[0]; xv[1] = r0[1]; xv[2] = r0[2]; xv[3] = r0[3]; xv[4] = r1[0]; xv[5] = r1[1]; xv[6] = r1[2]; xv[7] = r1[3]; }
                    uv[0] += xv[0] * w0[0]; uv[1] += xv[1] * w0[1]; uv[2] += xv[2] * w0[2]; uv[3] += xv[3] * w0[3]; uv[4] += xv[4] * w1[0]; uv[5] += xv[5] * w1[1]; uv[6] += xv[6] * w1[2]; uv[7] += xv[7] * w1[3]; }
            }
            ua[ks] = __builtin_bit_cast(bf16x8, (u32x4){cvt_pk_bf16(uv[0], uv[1]), cvt_pk_bf16(uv[2], uv[3]), cvt_pk_bf16(uv[4], uv[5]), cvt_pk_bf16(uv[6], uv[7])}); }
#pragma unroll
        for (int nt = 0; nt < 4; ++nt) {
            f32x4 ga = (f32x4){0.f, 0.f, 0.f, 0.f}, gi = ga, gu = ga;
            const int wrow = 16 * nt + fr, wsw = wrow & 7; const unsigned char* wr_ = wl + wrow * 128;
            const bf16x8 wa0 = *(const bf16x8*)(wr_ + ((kq ^ wsw) << 4)), wa1 = *(const bf16x8*)(wr_ + (((4 + kq) ^ wsw) << 4)), wi0 = *(const bf16x8*)(wr_ + 8192 + ((kq ^ wsw) << 4)), wi1 = *(const bf16x8*)(wr_ + 8192 + (((4 + kq) ^ wsw) << 4));
            ga = __builtin_amdgcn_mfma_f32_16x16x32_bf16(ua[0], wa0, ga, 0, 0, 0); ga = __builtin_amdgcn_mfma_f32_16x16x32_bf16(ua[1], wa1, ga, 0, 0, 0);
            gi = __builtin_amdgcn_mfma_f32_16x16x32_bf16(ua[0], wi0, gi, 0, 0, 0); gi = __builtin_amdgcn_mfma_f32_16x16x32_bf16(ua[1], wi1, gi, 0, 0, 0);
            {
                const bool on = kq == ((16 * (nt & 1) + fr) >> 3); const int e = fr & 7; u32x4 idw = (u32x4){0u, 0u, 0u, 0u};
                const unsigned one = (e & 1) ? 0x3f800000u : 0x00003f80u;
                if (on) { if ((e >> 1) == 0) idw.x = one; else if ((e >> 1) == 1) idw.y = one; else if ((e >> 1) == 2) idw.z = one; else idw.w = one; }
                gu = __builtin_amdgcn_mfma_f32_16x16x32_bf16(ua[nt >> 1], __builtin_bit_cast(bf16x8, idw), gu, 0, 0, 0); }
            float av[4], bv[4];
#pragma unroll
            for (int j = 0; j < 4; ++j) { const float r = sigmoidf_(ga[j] + ba[nt]), ig = sigmoidf_(gi[j] + bi[nt]); const float la = r * lsl[nt];
                av[j] = __expf(la); { const float x2 = 2.f * la; const float ser = -x2 * (1.f + x2 * (0.5f + x2 * (0.16666667f + x2 * (0.041666668f + x2 * 0.0083333338f)))); const float alt = __builtin_fmaf(-av[j], av[j], 1.f); const float om = x2 > -0.125f ? ser : alt; bv[j] = __builtin_amdgcn_sqrtf(om) * ig * gu[j]; }
                if (nvalid < 16 * m + 16 && 16 * m + 4 * kq + j >= nvalid) { av[j] = 1.f; bv[j] = 0.f; } }
            float Pj[4], Hj[4];
            if (!samp) {
                Pj[0] = av[0]; Hj[0] = bv[0];
#pragma unroll
                for (int j = 1; j < 4; ++j) { Pj[j] = av[j] * Pj[j - 1]; Hj[j] = av[j] * Hj[j - 1] + bv[j]; }
                float A = Pj[3], B = Hj[3];
                { const float Ap = __shfl_up(A, 16), Bp = __shfl_up(B, 16); if (kq >= 1) { B = A * Bp + B; A = A * Ap; } }
                { const float Ap = __shfl_up(A, 32), Bp = __shfl_up(B, 32); if (kq >= 2) { B = A * Bp + B; A = A * Ap; } }
                float Ae = __shfl_up(A, 16), Be = __shfl_up(B, 16); if (kq == 0) { Ae = 1.f; Be = 0.f; }
                const float A3 = __shfl(A, 48 + fr), B3 = __shfl(B, 48 + fr);
                const float cp = Ae * Pc[nt], chh = Be + Ae * Hc[nt];
#pragma unroll
                for (int j = 0; j < 4; ++j) { Hj[j] = Hj[j] + Pj[j] * chh; Pj[j] = Pj[j] * cp; }
                Hc[nt] = A3 * Hc[nt] + B3; Pc[nt] = A3 * Pc[nt];
            } else {
                const int bs = (16 * c + 16 * m) / 4 + kq; const int ch = 64 * blk + 16 * nt + fr;
                float h = h0v[nt];
#pragma unroll
                for (int j = 0; j < 4; ++j) { h = av[j] * h + bv[j]; Hj[j] = h; Pj[j] = 0.f; }
                out[OFF_SH + (size_t)(l * SB + bs) * 512 + ch] = h;
            }

            { const int rr0 = 16 * m + 4 * kq; const int ch = 64 * blk + 16 * nt + fr; bf16_t* mp = MRG + ((size_t)rowbase + rr0) * DM + 512 + ch; bf16_t* pp = PL + ((size_t)rowbase + rr0) * 512 + ch;
                if (nvalid >= 16 * m + 16) {
#pragma unroll
                    for (int j = 0; j < 4; ++j) { mp[j * DM] = (bf16_t)(cvt_pk_bf16(Hj[j], 0.f) & 0xffffu); pp[j * 512] = (bf16_t)(cvt_pk_bf16(Pj[j], 0.f) & 0xffffu); } }
                else {
#pragma unroll
                    for (int j = 0; j < 4; ++j) if (rr0 + j < nvalid) { mp[j * DM] = (bf16_t)(cvt_pk_bf16(Hj[j], 0.f) & 0xffffu); pp[j * 512] = (bf16_t)(cvt_pk_bf16(Pj[j], 0.f) & 0xffffu); } } }
        }
#pragma unroll
        for (int ks = 0; ks < 2; ++ks) { xprev[ks] = xcur[ks]; xcur[ks] = xnext[ks]; }
    }
    if (!samp && kq == 0) { float* agg = (float*)(ws + WS_AGG) + ((size_t)(b * NCH + c) * 512 + 64 * blk) * 2;
#pragma unroll
        for (int nt = 0; nt < 4; ++nt) *(f32x2*)(agg + (16 * nt + fr) * 2) = (f32x2){Pc[nt], Hc[nt]}; }
}
constexpr int KL_LD = 136, VL_LD = 200, VL_OFF = 192 * KL_LD * 2;
__device__ __forceinline__ void attn_wg_item(const Args& A, Ctx& C, unsigned char* ws, float* out, int l, int it) {
    const int lane = C.lane, n = lane & 15, kq = lane >> 4, h = C.wave, kvh = h >> 2;
    const int b = it / NCH, qt = it - b * NCH, t0 = 64 * qt, kbase = t0 - 128, nsub = (LP - t0 < 64 ? LP - t0 : 64) >> 4;
    const bf16_t* Q = (const bf16_t*)(ws + WS_Q); bf16_t* O = (bf16_t*)(ws + WS_MRG);
    const bf16_t* kP = (const bf16_t*)(ws + WS_KP) + (size_t)b * LP * 128; const bf16_t* vT = (const bf16_t*)(ws + WS_VTP) + (size_t)b * 128 * VTP_LD;
    bf16_t* Kl = (bf16_t*)C.lds; bf16_t* Vl = (bf16_t*)(C.lds + VL_OFF);
    bf16x8 qf[4][2];
#pragma unroll
    for (int sub = 0; sub < 4; ++sub) { const int tq = t0 + 16 * sub + n; const bool ok = tq < LP; const bf16_t* qp = Q + (size_t)(b * LP + (ok ? tq : 0)) * 512 + h * 64 + 8 * kq;
        qf[sub][0] = *(const bf16x8*)qp; qf[sub][1] = *(const bf16x8*)(qp + 32); }
    {
        u32x4 kr[6], vr[6];
#pragma unroll
        for (int i = 0; i < 6; ++i) { const int idx = i * 512 + C.tid; const int row = idx >> 4, ch8 = (idx & 15) * 8, t = kbase + row;
            kr[i] = (t >= 0 && t < LP) ? *(const u32x4*)(kP + (size_t)t * 128 + ch8) : (u32x4){0u, 0u, 0u, 0u};
            const int drow = idx / 24, ck = idx - drow * 24, tv = kbase + 8 * ck;
            vr[i] = tv >= 0 ? *(const u32x4*)(vT + (size_t)drow * VTP_LD + tv) : (u32x4){0u, 0u, 0u, 0u}; }
#pragma unroll
        for (int i = 0; i < 6; ++i) { const int idx = i * 512 + C.tid; const int row = idx >> 4, ch8 = (idx & 15) * 8; *(u32x4*)(Kl + row * KL_LD + ch8) = kr[i];
            const int drow = idx / 24, ck = idx - drow * 24; *(u32x4*)(Vl + drow * VL_LD + 8 * ck) = vr[i]; }
    }
    __syncthreads();
    const float sink = A.in[IN_SINK][l * 8 + h];
    for (int sub = 0; sub < nsub; ++sub) {
        const int tq = t0 + 16 * sub + n; const size_t qrow = (size_t)b * LP + tq;
        const bf16x8 q0 = sub == 0 ? qf[0][0] : sub == 1 ? qf[1][0] : sub == 2 ? qf[2][0] : qf[3][0], q1 = sub == 0 ? qf[0][1] : sub == 1 ? qf[1][1] : sub == 2 ? qf[2][1] : qf[3][1];
        f32x4 s[9]; float mx = sink;
#pragma unroll
        for (int T = 0; T < 9; ++T) { const bf16_t* kp = Kl + (16 * (sub + T) + n) * KL_LD + kvh * 64 + 8 * kq; const bf16x8 k0 = *(const bf16x8*)kp, k1 = *(const bf16x8*)(kp + 32);
            s[T] = (f32x4){0.f, 0.f, 0.f, 0.f};
            s[T] = __builtin_amdgcn_mfma_f32_16x16x32_bf16(k0, q0, s[T], 0, 0, 0); s[T] = __builtin_amdgcn_mfma_f32_16x16x32_bf16(k1, q1, s[T], 0, 0, 0);
#pragma unroll
            for (int j = 0; j < 4; ++j) { const int key = kbase + 16 * (sub + T) + 4 * kq + j; const bool ok = (key >= 0) && (key <= tq) && (key > tq - 128); s[T][j] = ok ? s[T][j] : -INFINITY; mx = fmaxf(mx, s[T][j]); } }
        mx = fmaxf(mx, __shfl_xor(mx, 16)); mx = fmaxf(mx, __shfl_xor(mx, 32));
        float sum = 0.f; u32x2 pk[9];
#pragma unroll
        for (int T = 0; T < 9; ++T) { float p[4];
#pragma unroll
            for (int j = 0; j < 4; ++j) { p[j] = __expf(s[T][j] - mx); sum += p[j]; }
            pk[T] = (u32x2){cvt_pk_bf16(p[0], p[1]), cvt_pk_bf16(p[2], p[3])}; }
        sum += __shfl_xor(sum, 16); sum += __shfl_xor(sum, 32);
        sum += __expf(sink - mx);
        const float rl = __builtin_amdgcn_rcpf(sum);
        f32x4 o[4];
#pragma unroll
        for (int dt = 0; dt < 4; ++dt) o[dt] = (f32x4){0.f, 0.f, 0.f, 0.f};
#pragma unroll
        for (int pr = 0; pr < 5; ++pr) { const int Ta = 2 * pr - 1, Tb = 2 * pr;
            const u32x2 pa = Ta >= 0 ? pk[Ta < 0 ? 0 : Ta] : (u32x2){0u, 0u}, pb = pk[Tb];
            const bf16x8 pf = __builtin_bit_cast(bf16x8, (u32x4){pa.x, pa.y, pb.x, pb.y});
#pragma unroll
            for (int dt = 0; dt < 4; ++dt) { const bf16_t* vp = Vl + (kvh * 64 + 16 * dt + n) * VL_LD + 4 * kq;
                const u32x2 va = *(const u32x2*)(vp + 16 * (sub + (Ta < 0 ? 0 : Ta))), vb = *(const u32x2*)(vp + 16 * (sub + Tb));
                const bf16x8 vf = __builtin_bit_cast(bf16x8, (u32x4){va.x, va.y, vb.x, vb.y});
                o[dt] = __builtin_amdgcn_mfma_f32_16x16x32_bf16(vf, pf, o[dt], 0, 0, 0); } }
#pragma unroll
        for (int dt = 0; dt < 4; ++dt) *(u32x2*)(O + qrow * DM + h * 64 + 16 * dt + 4 * kq) = (u32x2){cvt_pk_bf16(o[dt][0] * rl, o[dt][1] * rl), cvt_pk_bf16(o[dt][2] * rl, o[dt][3] * rl)};
    }
    __syncthreads();
}
__device__ __forceinline__ void p2_mixer(const Args& A, Ctx& C, int l) {
    OPQ_PTRS; asm volatile("" : "+s"(l)); asm volatile("" : "+v"(C.lane), "+v"(C.tid));
    constexpr int N_LRU = NB * NCH * 8 + 32 * 8, N_ATTP = NB * 129 * 8, N_SAMP = SB * 2;
    for (int it = C.vcu; it < NB * NCH; it += 256) attn_wg_item(A, C, ws, out, l, it);
    unsigned char* wl = C.lds + C.wave * 16384; float* cwl = (float*)(C.lds + 131072 + 64 + C.wave * 2304);
    { const int blk = C.wave; const bf16_t* lwA = (const bf16_t*)(ws + WS_LRUW) + (size_t)(l * 8 + blk) * 4096; const bf16_t* lwI = lwA + DEPTH * 8 * 4096;
        u32x4 ta[8], ti[8];
#pragma unroll
        for (int i = 0; i < 8; ++i) { ta[i] = *((const u32x4*)lwA + i * 64 + C.lane); ti[i] = *((const u32x4*)lwI + i * 64 + C.lane); }
        float cv[5];
#pragma unroll
        for (int j = 0; j < 4; ++j) cv[j] = A.in[IN_CONVW][(size_t)l * 4 * 512 + j * 512 + 64 * blk + C.lane];
        cv[4] = A.in[IN_CONVB][l * 512 + 64 * blk + C.lane];
    const float sba = A.in[IN_BA][l * 512 + 64 * blk + C.lane], sbi = A.in[IN_BI][l * 512 + 64 * blk + C.lane], slm = A.in[IN_LAM][l * 512 + 64 * blk + C.lane];
#pragma unroll
        for (int i = 0; i < 8; ++i) { const int idx = i * 64 + C.lane, row = idx >> 3, ch = idx & 7; *(u32x4*)(wl + row * 128 + ((ch ^ (row & 7)) << 4)) = ta[i]; *(u32x4*)(wl + 8192 + row * 128 + ((ch ^ (row & 7)) << 4)) = ti[i]; }
#pragma unroll
        for (int j = 0; j < 5; ++j) cwl[j * 64 + C.lane] = cv[j];
    cwl[320 + C.lane] = sba; cwl[384 + C.lane] = sbi; cwl[448 + C.lane] = 8.0f * (fminf(slm, 0.f) - log1pf(__expf(-fabsf(slm))));
        asm volatile("s_waitcnt lgkmcnt(0)" ::: "memory"); }
    for (int it = (255 - C.vcu) * NWAVES + C.wave; it < N_LRU + N_SAMP; it += 256 * NWAVES) { if (it < N_LRU) lru_item(A, C, ws, out, l, it, wl, cwl); else attn_item(A, C, ws, out, l, N_ATTP + it - N_LRU); }
    __syncthreads();
}
__device__ __forceinline__ void p3_fixup(const Args& A, Ctx& C, int l) {
    OPQ_PTRS; asm volatile("" : "+s"(l)); asm volatile("" : "+v"(C.lane), "+v"(C.tid));
    float* hin = (float*)C.lds; bf16_t* MRG = (bf16_t*)(ws + WS_MRG); const bf16_t* PL = (const bf16_t*)(ws + WS_PL); const bf16_t* G = (const bf16_t*)(ws + WS_G);
    const float* agg = (const float*)(ws + WS_AGG);
    for (int it = C.vcu; it < NB * NCH + 8 + 2; it += 256) {
        __syncthreads();
        if (it >= NB * NCH + 8) {
            const int r0 = MV + 64 * (it - NB * NCH - 8);
            for (int e = C.tid; e < 64 * 128; e += NTHREADS) *((u32x4*)(MRG + (size_t)r0 * DM) + e) = (u32x4){0u, 0u, 0u, 0u};
            continue; }
        const bool samp = it >= NB * NCH;
        int b, c; if (it < 256) { b = it >> 5; c = it & 31; } else { b = it - 256; c = NCH - 1; }
        const int rowbase = samp ? MP + 64 * (it - NB * NCH) : b * LP + 64 * c; const int nvalid = samp ? 64 : (LP - 64 * c < 64 ? LP - 64 * c : 64);
        float h = 0.f;
        if (!samp) { const f32x2* ap = (const f32x2*)agg + (size_t)b * NCH * 512 + C.tid;
            for (int c0 = 0; c0 < c; c0 += 8) { f32x2 ab[8];
#pragma unroll
                for (int k = 0; k < 8; ++k) ab[k] = (c0 + k < c) ? ap[(size_t)(c0 + k) * 512] : (f32x2){1.f, 0.f};
#pragma unroll
                for (int k = 0; k < 8; ++k) h = ab[k][0] * h + ab[k][1]; }
            if (c == NCH - 1) { const f32x2 ab = ap[(size_t)c * 512]; out[OFF_PH + (size_t)(l * NB + b) * 512 + C.tid] = ab[0] * h + ab[1]; } }
        hin[C.tid] = h;
        __syncthreads();
        float hv[8];
#pragma unroll
        for (int e = 0; e < 8; ++e) hv[e] = hin[8 * C.lane + e];
        for (int r0 = C.wave; r0 < nvalid; r0 += 4 * NWAVES) {
            u32x4 a[4], hl[4], pl[4], g[4]; bool ok[4];
#pragma unroll
            for (int q = 0; q < 4; ++q) { const int r = r0 + 8 * q; ok[q] = r < nvalid; const size_t row = (size_t)rowbase + (ok[q] ? r : r0);
                a[q] = *((const u32x4*)(MRG + row * DM) + C.lane); hl[q] = *((const u32x4*)(MRG + row * DM + 512) + C.lane); pl[q] = *((const u32x4*)(PL + row * 512) + C.lane); g[q] = *((const u32x4*)(G + row * 512) + C.lane); }
            float av[4][8], ov[4][8], sa[4], so[4];
#pragma unroll
            for (int q = 0; q < 4; ++q) {
                const float a8[8] = {bflo(a[q].x), bfhi(a[q].x), bflo(a[q].y), bfhi(a[q].y), bflo(a[q].z), bfhi(a[q].z), bflo(a[q].w), bfhi(a[q].w)};
                const float hlv[8] = {bflo(hl[q].x), bfhi(hl[q].x), bflo(hl[q].y), bfhi(hl[q].y), bflo(hl[q].z), bfhi(hl[q].z), bflo(hl[q].w), bfhi(hl[q].w)};
                const float plv[8] = {bflo(pl[q].x), bfhi(pl[q].x), bflo(pl[q].y), bfhi(pl[q].y), bflo(pl[q].z), bfhi(pl[q].z), bflo(pl[q].w), bfhi(pl[q].w)};
                const float gv[8] = {bflo(g[q].x), bfhi(g[q].x), bflo(g[q].y), bfhi(g[q].y), bflo(g[q].z), bfhi(g[q].z), bflo(g[q].w), bfhi(g[q].w)};
                sa[q] = 0.f; so[q] = 0.f;
#pragma unroll
                for (int e = 0; e < 8; ++e) { av[q][e] = a8[e]; ov[q][e] = (hlv[e] + plv[e] * hv[e]) * gv[e]; sa[q] += a8[e] * a8[e]; so[q] += ov[q][e] * ov[q][e]; } }
#pragma unroll
            for (int o = 1; o < 64; o <<= 1) {
#pragma unroll
                for (int q = 0; q < 4; ++q) { sa[q] += __shfl_xor(sa[q], o); so[q] += __shfl_xor(so[q], o); } }
#pragma unroll
            for (int q = 0; q < 4; ++q) { if (!ok[q]) continue; const size_t row = (size_t)rowbase + r0 + 8 * q;
                const float ra = rsqrtf(sa[q] * (1.f / 512.f) + EPS), ro = rsqrtf(so[q] * (1.f / 512.f) + EPS);
                *((u32x4*)(MRG + row * DM) + C.lane) = (u32x4){cvt_pk_bf16(av[q][0] * ra, av[q][1] * ra), cvt_pk_bf16(av[q][2] * ra, av[q][3] * ra), cvt_pk_bf16(av[q][4] * ra, av[q][5] * ra), cvt_pk_bf16(av[q][6] * ra, av[q][7] * ra)};
                *((u32x4*)(MRG + row * DM + 512) + C.lane) = (u32x4){cvt_pk_bf16(ov[q][0] * ro, ov[q][1] * ro), cvt_pk_bf16(ov[q][2] * ro, ov[q][3] * ro), cvt_pk_bf16(ov[q][4] * ro, ov[q][5] * ro), cvt_pk_bf16(ov[q][6] * ro, ov[q][7] * ro)}; }
        }
    }
}
__device__ __forceinline__ void fixup_slab(const Args& A, Ctx& C, int l, int r0, unsigned* slabcnt, const unsigned* xcc_of, int pm) {
    OPQ_PTRS; asm volatile("" : "+s"(l), "+s"(r0)); asm volatile("" : "+v"(C.lane), "+v"(C.tid));
    float* hin = (float*)C.lds;
    bf16_t* MRG = (bf16_t*)(ws + WS_MRG); const bf16_t* PL = (const bf16_t*)(ws + WS_PL); const float* agg = (const float*)(ws + WS_AGG);
    const bf16_t* G = (const bf16_t*)(ws + WS_G) + (r0 >= (int)TAIL_ROW0 ? G_DELTA : 0);
    int pos1 = 64, pos2 = 64;
    if (r0 >= MV) { for (int e = C.tid; e < 64 * 128; e += NTHREADS) *((u32x4*)(MRG + (size_t)r0 * DM) + e) = (u32x4){0u, 0u, 0u, 0u}; }
    else {
        if (r0 >= MP) { hin[C.tid] = 0.f; }
        else {
            const int b0 = r0 / LP, t0 = r0 - b0 * LP, c0 = t0 >> 6;
            const int end0 = (64 * (c0 + 1) < LP ? 64 * (c0 + 1) : LP) - t0;
            float h = 0.f;
            { const f32x2* ap = (const f32x2*)agg + (size_t)b0 * NCH * 512 + C.tid; f32x2 ab[32];
#pragma unroll
                for (int k = 0; k < 32; ++k) ab[k] = (k < c0) ? ap[(size_t)k * 512] : (f32x2){1.f, 0.f};
#pragma unroll
                for (int k = 0; k < 32; ++k) h = ab[k][0] * h + ab[k][1];
                hin[C.tid] = h;
                int b = b0, c = c0, pos = end0 < 64 ? end0 : 64;
                if (c == NCH - 1) { const f32x2 abl = ap[(size_t)c * 512]; out[OFF_PH + (size_t)(l * NB + b) * 512 + C.tid] = abl[0] * h + abl[1]; }
                if (pos < 64) {
                    pos1 = pos;
                    if (t0 + pos == LP) { b = b0 + 1; c = 0; h = 0.f; } else { const f32x2 x = ap[(size_t)c * 512]; h = x[0] * h + x[1]; c = c + 1; }
                    hin[512 + C.tid] = h;
                    const int tcur = (b == b0) ? t0 + pos : 0; const int cend = (64 * (c + 1) < LP ? 64 * (c + 1) : LP) - tcur; const int len1 = cend < 64 - pos ? cend : 64 - pos;
                    if (b == b0 && c == NCH - 1) { const f32x2 abl = ap[(size_t)c * 512]; out[OFF_PH + (size_t)(l * NB + b) * 512 + C.tid] = abl[0] * h + abl[1]; }
                    pos += len1;
                    if (pos < 64) {
                        pos2 = pos; hin[1024 + C.tid] = 0.f; } } }
        }
        __syncthreads();
        for (int rr = C.wave; rr < 64; rr += 4 * NWAVES) {
            u32x4 a[4], hl[4], pl[4], g[4]; int sg[4];
#pragma unroll
            for (int q = 0; q < 4; ++q) { const int r = rr + 8 * q; const size_t row = (size_t)r0 + r; sg[q] = (r >= pos1 ? 1 : 0) + (r >= pos2 ? 1 : 0);
                a[q] = *((const u32x4*)(MRG + row * DM) + C.lane); hl[q] = *((const u32x4*)(MRG + row * DM + 512) + C.lane); pl[q] = *((const u32x4*)(PL + row * 512) + C.lane); g[q] = *((const u32x4*)(G + row * 512) + C.lane); }
            float av[4][8], ov[4][8], sa[4], so[4];
#pragma unroll
            for (int q = 0; q < 4; ++q) {
                const float* hq = hin + 512 * sg[q] + 8 * C.lane; const f32x4 h0 = *(const f32x4*)hq, h1 = *(const f32x4*)(hq + 4); const float hv[8] = {h0[0], h0[1], h0[2], h0[3], h1[0], h1[1], h1[2], h1[3]};
                const float a8[8] = {bflo(a[q].x), bfhi(a[q].x), bflo(a[q].y), bfhi(a[q].y), bflo(a[q].z), bfhi(a[q].z), bflo(a[q].w), bfhi(a[q].w)};
                const float hlv[8] = {bflo(hl[q].x), bfhi(hl[q].x), bflo(hl[q].y), bfhi(hl[q].y), bflo(hl[q].z), bfhi(hl[q].z), bflo(hl[q].w), bfhi(hl[q].w)};
                const float plv[8] = {bflo(pl[q].x), bfhi(pl[q].x), bflo(pl[q].y), bfhi(pl[q].y), bflo(pl[q].z), bfhi(pl[q].z), bflo(pl[q].w), bfhi(pl[q].w)};
                const float gv[8] = {bflo(g[q].x), bfhi(g[q].x), bflo(g[q].y), bfhi(g[q].y), bflo(g[q].z), bfhi(g[q].z), bflo(g[q].w), bfhi(g[q].w)};
                sa[q] = 0.f; so[q] = 0.f;
#pragma unroll
                for (int e = 0; e < 8; ++e) { av[q][e] = a8[e]; ov[q][e] = (hlv[e] + plv[e] * hv[e]) * gv[e]; sa[q] += a8[e] * a8[e]; so[q] += ov[q][e] * ov[q][e]; } }
#pragma unroll
            for (int o = 1; o < 64; o <<= 1) {
#pragma unroll
                for (int q = 0; q < 4; ++q) { sa[q] += __shfl_xor(sa[q], o); so[q] += __shfl_xor(so[q], o); } }
#pragma unroll
            for (int q = 0; q < 4; ++q) { const size_t row = (size_t)r0 + rr + 8 * q;
                const float ra = rsqrtf(sa[q] * (1.f / 512.f) + EPS), ro = rsqrtf(so[q] * (1.f / 512.f) + EPS);
                *((u32x4*)(MRG + row * DM) + C.lane) = (u32x4){cvt_pk_bf16(av[q][0] * ra, av[q][1] * ra), cvt_pk_bf16(av[q][2] * ra, av[q][3] * ra), cvt_pk_bf16(av[q][4] * ra, av[q][5] * ra), cvt_pk_bf16(av[q][6] * ra, av[q][7] * ra)};
                *((u32x4*)(MRG + row * DM + 512) + C.lane) = (u32x4){cvt_pk_bf16(ov[q][0] * ro, ov[q][1] * ro), cvt_pk_bf16(ov[q][2] * ro, ov[q][3] * ro), cvt_pk_bf16(ov[q][4] * ro, ov[q][5] * ro), cvt_pk_bf16(ov[q][6] * ro, ov[q][7] * ro)}; }
        }
    }
    asm volatile("s_waitcnt vmcnt(0)" ::: "memory"); __syncthreads();
    if (C.wave == 0) {
        const unsigned my = ((unsigned)__builtin_amdgcn_s_getreg((3 << 11) | 20) & 0xFu) + 1u;
        const unsigned v = (pm < 64 && C.lane < 4) ? __hip_atomic_load(xcc_of + 4 * pm + C.lane, __ATOMIC_RELAXED, __HIP_MEMORY_SCOPE_AGENT) : (pm < 64 ? my : 0u);
        if (__builtin_amdgcn_ballot_w64(v != my) != 0ull) __builtin_amdgcn_fence(__ATOMIC_RELEASE, "agent");
        asm volatile("s_waitcnt vmcnt(0)" ::: "memory");
        if (C.lane == 0) __hip_atomic_fetch_add(slabcnt + 64 * pm, 1u, __ATOMIC_RELAXED, __HIP_MEMORY_SCOPE_AGENT);
        unsigned spins = 0;
        while ((unsigned)__builtin_amdgcn_readfirstlane(__hip_atomic_load(slabcnt + 64 * pm, __ATOMIC_RELAXED, __HIP_MEMORY_SCOPE_AGENT)) < 4u) { if (++spins > (1u << 22)) break; __builtin_amdgcn_s_sleep(2); }
        __builtin_amdgcn_fence(__ATOMIC_ACQUIRE, "agent"); asm volatile("s_waitcnt vmcnt(0)" ::: "memory"); }
    __syncthreads();
}
__global__ void __launch_bounds__(NTHREADS) hymba_fwd(Args args) {
    const Args& A = args;
    extern __shared__ __attribute__((aligned(16))) unsigned char lds[];
    cg::grid_group grid = cg::this_grid();
    Ctx C;
    C.lds = lds;
    C.tid = threadIdx.x; C.lane = C.tid & 63; C.wave = __builtin_amdgcn_readfirstlane(C.tid >> 6);
    { const int bx = blockIdx.x; C.vcu = (bx % 8) * 32 + bx / 8; }
    C.gw = C.vcu * NWAVES + C.wave;
    PG8_LAS unsigned char* ring = (PG8_LAS unsigned char*)lds;
    volatile __attribute__((address_space(3))) unsigned* xb_st = (volatile __attribute__((address_space(3))) unsigned*)((PG8_LAS unsigned char*)lds + 131072);
    if (threadIdx.x < 2) xb_st[threadIdx.x] = 0u;
    __syncthreads();
    { u32x4* cz = (u32x4*)(args.ws + WS_CTL); for (int i = blockIdx.x * NTHREADS + threadIdx.x; i < (int)(CTL_BYTES / 16); i += 256 * NTHREADS) cz[i] = (u32x4){0u, 0u, 0u, 0u}; }
#ifndef NO_P0
    p0_prologue(A, C);
#endif
    grid.sync();
    XcdBarrier xbar = xcd_barrier_post((unsigned*)(args.ws + WS_CTL) + CW_XBAR, xb_st);
    if (threadIdx.x == 0) __hip_atomic_store((unsigned*)(args.ws + WS_CTL) + CW_XCC + C.vcu, xbar.x + 1u, __ATOMIC_RELAXED, __HIP_MEMORY_SCOPE_AGENT);
    for (int l = 0; l < DEPTH; ++l) {
#ifndef NO_P1
        {
            OPQ_PTRS; int ll = l; asm volatile("" : "+s"(ll)); const unsigned char* wb = ws + WS_W + (size_t)ll * W_LAYER_B; unsigned* ctl = (unsigned*)(ws + WS_CTL); float* xmeta = (float*)(ws + WS_XMETA); float* xss = (float*)(ws + WS_XSS); bf16_t* xb16 = (bf16_t*)(ws + WS_XB16); (void)ctl; (void)xmeta; (void)wb;
            pg8::Gemm g{xb16, (const bf16_t*)wb, MPAD, IN_W, DM}; pg8::GatedOrder S{C.vcu, 7, 1, ctl + CW_READY + (ll > 0 ? 2 * ll - 1 : 0) * SEAM_BANK, ctl + CW_GD16 + (ll > 0 ? 2 * ll - 1 : 0) * 1024, ll > 0 ? 32u : 0u, 0};
            pg8::EpiIn E{xss, (bf16_t*)(ws + WS_Q), (bf16_t*)(ws + WS_KP), (bf16_t*)(ws + WS_VTP), (bf16_t*)(ws + WS_KS), (bf16_t*)(ws + WS_VTS), (bf16_t*)(ws + WS_XBC), (bf16_t*)(ws + WS_G), out, ll};
            pg8::gemm_phase<pg8::EpiIn, pg8::GatedOrder, true, true>(ring, g, S, E);
        }
#endif
        xcd_barrier(xbar);
#ifndef NO_P2
        p2_mixer(A, C, l);
#endif
        xcd_barrier(xbar);
#ifndef NO_P4
        for (int round = 0; round < 2; ++round) {
            OPQ_PTRS; int ll = l; asm volatile("" : "+s"(ll)); const unsigned char* wb = ws + WS_W + (size_t)ll * W_LAYER_B; unsigned* ctl = (unsigned*)(ws + WS_CTL); float* xmeta = (float*)(ws + WS_XMETA); float* xss = (float*)(ws + WS_XSS); bf16_t* xb16 = (bf16_t*)(ws + WS_XB16); (void)ctl; (void)xmeta; (void)wb;
            pg8::Gemm g{(const bf16_t*)(ws + WS_MRG), (const bf16_t*)(wb + W_IN_B), MPAD, DM, DM}; pg8::PanelOrder S{C.vcu, round, nullptr};
            pg8::EpiRes E{out, 0, xb16, xss, A.in[IN_POSTMIX] + ll * DM, (unsigned*)(ws + WS_XBUF), ctl + CW_SEAM + (2 * ll) * SEAM_BANK, ctl + CW_READY + (2 * ll) * SEAM_BANK, ctl + CW_GD16 + (2 * ll) * 1024, ctl + CW_XCC};
            { pg8::Unit su; if (S.next(0, su)) fixup_slab(A, C, l, 256 * su.pm + 64 * su.pn, ctl + CW_SLAB + ll * SEAM_BANK, ctl + CW_XCC, su.pm); }
            pg8::gemm_phase<pg8::EpiRes, pg8::PanelOrder, false, true>(ring, g, S, E);
            __syncthreads();
        }
#endif
#ifndef NO_P6
        {
            OPQ_PTRS; int ll = l; asm volatile("" : "+s"(ll)); const unsigned char* wb = ws + WS_W + (size_t)ll * W_LAYER_B; unsigned* ctl = (unsigned*)(ws + WS_CTL); float* xmeta = (float*)(ws + WS_XMETA); float* xss = (float*)(ws + WS_XSS); bf16_t* xb16 = (bf16_t*)(ws + WS_XB16); (void)ctl; (void)xmeta; (void)wb;
            pg8::Gemm g{xb16, (const bf16_t*)(wb + W_IN_B + W_OUT_B), MPAD, 2 * D_FF, DM}; pg8::GatedOrder S{C.vcu, 22, 2, ctl + CW_READY + (2 * ll) * SEAM_BANK, ctl + CW_GD16 + (2 * ll) * 1024, 32u, 0};
            pg8::EpiGU E{xss, (bf16_t*)(ws + WS_HACT)};
            pg8::gemm_phase<pg8::EpiGU, pg8::GatedOrder, true, true>(ring, g, S, E);
            __syncthreads();
            if (C.wave == 0) { const unsigned my = ((unsigned)__builtin_amdgcn_s_getreg((3 << 11) | 20) & 0xFu) + 1u;
                const unsigned v = C.lane < 32 ? __hip_atomic_load(ctl + CW_XCC + (C.vcu & ~31) + C.lane, __ATOMIC_RELAXED, __HIP_MEMORY_SCOPE_AGENT) : my;
                if (__builtin_amdgcn_ballot_w64(v != my) != 0ull) __builtin_amdgcn_fence(__ATOMIC_RELEASE, "agent");
                asm volatile("s_waitcnt vmcnt(0)" ::: "memory");
                if (C.lane == 0) __hip_atomic_fetch_add(ctl + CW_GRP + ll * 512 + 64 * (C.vcu >> 5), 1u, __ATOMIC_RELAXED, __HIP_MEMORY_SCOPE_AGENT); }
        }
#endif
#ifndef NO_P7
        for (int round = 0; round < 2; ++round) {
            OPQ_PTRS; int ll = l; asm volatile("" : "+s"(ll)); const unsigned char* wb = ws + WS_W + (size_t)ll * W_LAYER_B; unsigned* ctl = (unsigned*)(ws + WS_CTL); float* xmeta = (float*)(ws + WS_XMETA); float* xss = (float*)(ws + WS_XSS); bf16_t* xb16 = (bf16_t*)(ws + WS_XB16); (void)ctl; (void)xmeta; (void)wb;
            pg8::Gemm g{(const bf16_t*)(ws + WS_HACT), (const bf16_t*)(wb + W_IN_B + W_OUT_B + W_GU_B), MPAD, DM, D_FF}; pg8::PanelOrder S{C.vcu, round, ctl + CW_GRP + ll * 512};
            pg8::EpiRes E{out, ll == DEPTH - 1 ? 1 : 0, xb16, xss, A.in[IN_POSTFFN] + ll * DM, (unsigned*)(ws + WS_XBUF), ctl + CW_SEAM + (2 * ll + 1) * SEAM_BANK, ctl + CW_READY + (2 * ll + 1) * SEAM_BANK, ctl + CW_GD16 + (2 * ll + 1) * 1024, ctl + CW_XCC};
            pg8::gemm_phase<pg8::EpiRes, pg8::PanelOrder, false, true>(ring, g, S, E);
            __syncthreads();
        }
#endif
    }
}

extern "C" void kernel_launch(void* const* d_in, const int* in_sizes, int n_in, void* d_out, int out_size, void* d_ws, size_t ws_size, hipStream_t stream) {
    static int grid = 0;
    if (grid == 0) {
        if (n_in != 26 || ws_size < WS_END) { fprintf(stderr, "kernel_launch: unexpected inputs (n_in %d, ws %zu)\n", n_in, ws_size); grid = -1; return; }
        int dev = 0, cus = 0, per_cu = 0;
        (void)hipGetDevice(&dev); (void)hipDeviceGetAttribute(&cus, hipDeviceAttributeMultiprocessorCount, dev);
        if (hipFuncSetAttribute((const void*)hymba_fwd, hipFuncAttributeMaxDynamicSharedMemorySize, LDS_BYTES) != hipSuccess) { fprintf(stderr, "kernel_launch: hipFuncSetAttribute failed\n"); grid = -1; return; }
        if (hipOccupancyMaxActiveBlocksPerMultiprocessor(&per_cu, (const void*)hymba_fwd, NTHREADS, LDS_BYTES) != hipSuccess || per_cu < 1) { fprintf(stderr, "kernel_launch: occupancy query says %d\n", per_cu); grid = -1; return; }
        if (cus < 256) { fprintf(stderr, "kernel_launch: needs 256 CUs, device has %d\n", cus); grid = -1; return; }
        grid = 256;
    }
    if (grid < 0) return;
    Args a{};
    for (int i = 0; i < 26; ++i) a.in[i] = (const float*)d_in[i];
    a.out = (float*)d_out; a.ws = (unsigned char*)d_ws;
    void* kargs[] = {&a};
    hipError_t e = hipLaunchCooperativeKernel((const void*)hymba_fwd, dim3(grid), dim3(NTHREADS), kargs, LDS_BYTES, stream);
    if (e != hipSuccess) fprintf(stderr, "cooperative launch failed: %s\n", hipGetErrorString(e));
}
```

```cpp
#include <hip/hip_runtime.h>
#include <hip/hip_cooperative_groups.h>
#include <cstdio>
#include <cstdint>
namespace cg = cooperative_groups;

constexpr int DM = 1024, NB = 8, SEQ = 2048, LP = 2064, DEPTH = 4, SB = 128, SS = 4, NMETA = 16;
constexpr int ATT_W = 512, LRU_W = 512, D_FF = 2816, IN_W = 1792;
constexpr int MP = NB * LP;
constexpr int MS = SB * SS;
constexpr int MV = MP + MS;
constexpr int MPAD = 17152;
constexpr int NCH = 33;
constexpr int VTP_LD = 2080, VTS_LD = 144, KS_ROWS = 144;
constexpr float EPS = 1e-6f;
constexpr size_t OFF_YP = 0, OFF_YS = OFF_YP + (size_t)NB * SEQ * DM, OFF_PK = OFF_YS + (size_t)MS * DM, OFF_PV = OFF_PK + (size_t)DEPTH * NB * 128 * 128,
                 OFF_PH = OFF_PV + (size_t)DEPTH * NB * 128 * 128, OFF_PC = OFF_PH + (size_t)DEPTH * NB * 512, OFF_SK = OFF_PC + (size_t)DEPTH * NB * 3 * 512,
                 OFF_SV = OFF_SK + (size_t)DEPTH * SB * 128 * 128, OFF_SH = OFF_SV + (size_t)DEPTH * SB * 128 * 128, OFF_SC = OFF_SH + (size_t)DEPTH * SB * 512;
constexpr size_t MiB = 1u << 20;
constexpr size_t WS_CTL = 0, CTL_BYTES = 1 * MiB, WS_XMETA = 1 * MiB, WS_XSS = 2 * MiB, WS_XBUF = 4 * MiB, WS_AGG = 5 * MiB, WS_LRUW = 7 * MiB, WS_W = 8 * MiB;
constexpr size_t W_IN_B = (size_t)IN_W * DM * 2, W_OUT_B = (size_t)DM * DM * 2, W_GU_B = (size_t)2 * D_FF * DM * 2, W_D_B = (size_t)DM * D_FF * 2, W_LAYER_B = W_IN_B + W_OUT_B + W_GU_B + W_D_B;
constexpr size_t WS_XB16 = 96 * MiB, WS_KP = 130 * MiB, WS_VTP = 135 * MiB, WS_KS = 140 * MiB, WS_VTS = 158 * MiB;
constexpr size_t WS_Q = 176 * MiB, WS_XBC = 193 * MiB, WS_G = 210 * MiB, WS_PL = 252 * MiB + 256 * 1024, WS_MRG = 269 * MiB + 256 * 1024, WS_HACT = 176 * MiB, WS_GT = 303 * MiB, WS_END = 304 * MiB;
constexpr long TAIL_ROW0 = 16384, G_DELTA = (long)((WS_GT - WS_G) / 2) - TAIL_ROW0 * 512;
static_assert(WS_PL + (size_t)TAIL_ROW0 * 1024 >= WS_HACT + (size_t)MPAD * D_FF * 2 && WS_PL + (size_t)MPAD * 1024 <= WS_MRG && WS_MRG + (size_t)MPAD * 2048 <= WS_GT, "tail rows outside the hact overlay");
static_assert(WS_W + 4 * W_LAYER_B <= WS_XB16 && WS_HACT + (size_t)MPAD * D_FF * 2 <= WS_END, "ws map");
constexpr int CW_SEAM = 4096, SEAM_BANK = 128 * 64, CW_READY = 131072, CW_GDONE = 196608, CW_XBAR = 200704, CW_XCC = 208896, CW_GD16 = 212992, CW_SLAB = 221184, CW_GRP = 253952;

typedef unsigned short bf16_t;
typedef short bf16x8 __attribute__((ext_vector_type(8)));
typedef short bf16x4 __attribute__((ext_vector_type(4)));
typedef float f32x4 __attribute__((ext_vector_type(4)));
typedef float f32x2 __attribute__((ext_vector_type(2)));
typedef unsigned u32x4 __attribute__((ext_vector_type(4)));
typedef unsigned u32x2 __attribute__((ext_vector_type(2)));

__device__ __forceinline__ unsigned cvt_pk_bf16(float lo, float hi) { unsigned r; asm volatile("v_cvt_pk_bf16_f32 %0, %1, %2" : "=v"(r) : "v"(lo), "v"(hi)); return r; }
__device__ __forceinline__ float bf2f(unsigned short b) { return __uint_as_float((unsigned)b << 16); }
__device__ __forceinline__ float bflo(unsigned w) { return __uint_as_float(w << 16); }
__device__ __forceinline__ float bfhi(unsigned w) { return __uint_as_float(w & 0xffff0000u); }
__device__ __forceinline__ float gelu_tanh(float x) { const float y = 0.7978845608f * (x + 0.044715f * x * x * x); return x * __builtin_amdgcn_rcpf(1.f + __expf(-2.f * y)); }
__device__ __forceinline__ float sigmoidf_(float x) { return __builtin_amdgcn_rcpf(1.f + __expf(-x)); }
__device__ __forceinline__ float wave_sum(float v) {
#pragma unroll
    for (int o = 1; o < 64; o <<= 1) v += __shfl_xor(v, o);
    return v;
}
__device__ __forceinline__ float* xrow_ptr(float* out, float* xmeta, int row) {
    if (row < MP) { const int b = row / LP, t = row - b * LP; return t >= NMETA ? out + OFF_YP + ((size_t)b * SEQ + (t - NMETA)) * DM : xmeta + (size_t)(b * NMETA + t) * DM; }
    if (row < MV) return out + OFF_YS + (size_t)(row - MP) * DM;
    return xmeta + (size_t)(128 + row - MV) * DM;
}
namespace pg8 {
#define PG8_LAS __attribute__((address_space(3)))
typedef unsigned short bf16_t;
typedef short bf16x8 __attribute__((ext_vector_type(8)));
typedef float f32x4 __attribute__((ext_vector_type(4)));
typedef unsigned u32x4 __attribute__((ext_vector_type(4)));
constexpr int BM = 256, BK = 64, HALF = 128, HTB = HALF * BK * 2  , STAGE_BYTES = 8 * HTB, NXCD = 8, WGM = 8;

__host__ __device__ __forceinline__ int lds_byte(int r, int c) { const int st = (r >> 4) * 2 + (c >> 5), rr = r & 15, cc = c & 31, ob = rr * 64 + cc * 2; return st * 1024 + (ob ^ (((ob >> 9) & 1) << 5)); }
__host__ __device__ __forceinline__ void stage_rc(int b, int& R, int& C) { const int st = b / 1024, sb = b % 1024, swz = sb ^ (((sb >> 9) & 1) << 5); R = (st >> 1) * 16 + swz / 64; C = (st & 1) * 32 + (swz % 64) / 2; }
__host__ __device__ __forceinline__ int perm32(int rho) { const int n = rho >> 4, i = rho & 15; return 8 * (i >> 2) + 4 * n + (i & 3); }

struct Unit { int pm, pn; };
struct Gemm { const bf16_t* A; const bf16_t* Bt; int M, N, K; };

struct StaticOrder {
    int nM, nN, nwg, G, c;
    __host__ __device__ void init(int M, int N, int G_, int c_) { nM = M / BM; nN = N / BM; nwg = nM * nN; G = G_; c = c_; }
    __host__ __device__ bool next(int i, Unit& u) const {
        const long L = (long)i * G + c; if (L >= nwg) return false;
        int wgid = (int)L; { const int q = nwg / NXCD, r = nwg % NXCD, xcd = wgid % NXCD, off = wgid / NXCD; wgid = (xcd < r ? xcd * (q + 1) : r * (q + 1) + (xcd - r) * q) + off; }
        const int nig = WGM * nN, gid = wgid / nig, fm = gid * WGM, gsz = (nM - fm) < WGM ? (nM - fm) : WGM;
        u.pm = fm + ((wgid % nig) % gsz); u.pn = (wgid % nig) / gsz; return true;
    }
    __device__ __forceinline__ void a_ready(const Unit&) const {}
    __device__ __forceinline__ void done(const Unit&) const {}
};

__device__ __forceinline__ float row_rs(const float* xss, int row) {
    const f32x4 a = *(const f32x4*)(xss + (size_t)row * 4);
    return rsqrtf(((a[0] + a[1]) + (a[2] + a[3])) * (1.0f / 1024.0f) + EPS);
}
struct EpiIn {
    static constexpr bool PERM = true, AFTER_DRAIN = false;
    const float* xss; bf16_t *q, *kP, *vTP, *kS, *vTS, *xbc, *G; float* out; int layer;
    __device__ __forceinline__ void operator()(const f32x4 (&acc)[2][2][4][2], const Unit& u, int wr, int wc, int fr, int fq) const {
        const int l = layer;
        float rsv[2][4];
#pragma unroll
        for (int ai = 0; ai < 2; ++ai)
#pragma unroll
            for (int m = 0; m < 4; ++m) rsv[ai][m] = row_rs(xss, u.pm * BM + ai * HALF + wr * 64 + m * 16 + fr);
#pragma unroll
        for (int ai = 0; ai < 2; ++ai)
#pragma unroll
            for (int m = 0; m < 4; ++m) {
                const int row = u.pm * BM + ai * HALF + wr * 64 + m * 16 + fr;
                const float rs = rsv[ai][m];
                int kind, b, t; float pos;
                if (row < MP) { kind = 0; b = row / LP; t = row - b * LP; pos = (float)t; } else if (row < MV) { kind = 1; b = (row - MP) >> 2; t = (row - MP) & 3; pos = (float)(8192 + t); } else { kind = 2; b = 0; t = 0; pos = 0.f; }
                if (u.pn <= 2) {
                    float cs[4], sn[4];
                    if (u.pn < 2 || true) {
#pragma unroll
                        for (int j = 0; j < 4; ++j) { const int d = 16 * (wc & 1) + 8 * (fq & 1) + 4 * (fq >> 1) + j; const float inv = exp2f(-(float)d * 0.4152410118609203f); const float ang = pos * inv;
                            double rv = (double)ang * 0.15915494309189535; rv -= floor(rv); const float fv = (float)rv; cs[j] = __builtin_amdgcn_cosf(fv); sn[j] = __builtin_amdgcn_sinf(fv); }
                    }
                    if (u.pn < 2) {
#pragma unroll
                        for (int bj = 0; bj < 2; ++bj) { const int head = 4 * u.pn + 2 * bj + (wc >> 1); const f32x4 x1 = acc[ai][bj][m][0] * rs, x2 = acc[ai][bj][m][1] * rs; float o1[4], o2[4];
#pragma unroll
                            for (int j = 0; j < 4; ++j) { o1[j] = (x1[j] * cs[j] - x2[j] * sn[j]) * 0.125f; o2[j] = (x2[j] * cs[j] + x1[j] * sn[j]) * 0.125f; }
                            const unsigned a0 = cvt_pk_bf16(o1[0], o1[1]), a1 = cvt_pk_bf16(o1[2], o1[3]), b0 = cvt_pk_bf16(o2[0], o2[1]), b1 = cvt_pk_bf16(o2[2], o2[3]);
                            const auto rA = __builtin_amdgcn_permlane32_swap(a0, b0, false, false), rB = __builtin_amdgcn_permlane32_swap(a1, b1, false, false);
                            bf16_t* qp = q + (size_t)row * 512 + head * 64 + 16 * (wc & 1) + 8 * (fq & 1) + 32 * (fq >> 1);
                            *(u32x4*)qp = (u32x4){(unsigned)rA[0], (unsigned)rB[0], (unsigned)rA[1], (unsigned)rB[1]}; }
                    } else {
                        const int kvh = wc >> 1, d0 = 16 * (wc & 1) + 8 * (fq & 1) + 4 * (fq >> 1);
                        { const f32x4 x1 = acc[ai][0][m][0] * rs, x2 = acc[ai][0][m][1] * rs; f32x4 o1, o2;
#pragma unroll
                            for (int j = 0; j < 4; ++j) { o1[j] = x1[j] * cs[j] - x2[j] * sn[j]; o2[j] = x2[j] * cs[j] + x1[j] * sn[j]; }
                            const u32x2 w1 = (u32x2){cvt_pk_bf16(o1[0], o1[1]), cvt_pk_bf16(o1[2], o1[3])}, w2 = (u32x2){cvt_pk_bf16(o2[0], o2[1]), cvt_pk_bf16(o2[2], o2[3])};
                            if (kind == 0) { bf16_t* kp = kP + (size_t)row * 128 + kvh * 64 + d0; *(u32x2*)kp = w1; *(u32x2*)(kp + 32) = w2;
                                if (t >= LP - 128) { float* op = out + OFF_PK + ((size_t)(l * NB + b) * 128 + (t - (LP - 128))) * 128 + kvh * 64 + d0; *(f32x4*)op = o1; *(f32x4*)(op + 32) = o2; } }
                            else if (kind == 1) { bf16_t* kp = kS + ((size_t)(l * SB + b) * KS_ROWS + 128 + t) * 128 + kvh * 64 + d0; *(u32x2*)kp = w1; *(u32x2*)(kp + 32) = w2;
                                float* op = out + OFF_SK + ((size_t)(l * SB + b) * 128 + 124 + t) * 128 + kvh * 64 + d0; *(f32x4*)op = o1; *(f32x4*)(op + 32) = o2; } }
#pragma unroll
                        for (int n = 0; n < 2; ++n) { const f32x4 v = acc[ai][1][m][n] * rs; const int d = 32 * (wc & 1) + 8 * fq + 4 * n;
                            if (kind == 0) { bf16_t* vp = vTP + ((size_t)(b * 2 + kvh) * 64 + d) * VTP_LD + t;
#pragma unroll
                                for (int j = 0; j < 4; ++j) vp[(size_t)j * VTP_LD] = (bf16_t)(cvt_pk_bf16(v[j], 0.f) & 0xffffu);
                                if (t >= LP - 128) *(f32x4*)(out + OFF_PV + ((size_t)(l * NB + b) * 128 + (t - (LP - 128))) * 128 + kvh * 64 + d) = v; }
                            else if (kind == 1) { bf16_t* vp = vTS + ((size_t)((l * SB + b) * 2 + kvh) * 64 + d) * VTS_LD + 128 + t;
#pragma unroll
                                for (int j = 0; j < 4; ++j) vp[(size_t)j * VTS_LD] = (bf16_t)(cvt_pk_bf16(v[j], 0.f) & 0xffffu);
                                *(f32x4*)(out + OFF_SV + ((size_t)(l * SB + b) * 128 + 124 + t) * 128 + kvh * 64 + d) = v; } }
                    }
                } else if (u.pn <= 4) {
#pragma unroll
                    for (int bj = 0; bj < 2; ++bj) { const f32x4 v0 = acc[ai][bj][m][0] * rs, v1 = acc[ai][bj][m][1] * rs; const int col = 256 * (u.pn - 3) + 128 * bj + 32 * wc + 8 * fq;
                        *(u32x4*)(xbc + (size_t)row * 512 + col) = (u32x4){cvt_pk_bf16(v0[0], v0[1]), cvt_pk_bf16(v0[2], v0[3]), cvt_pk_bf16(v1[0], v1[1]), cvt_pk_bf16(v1[2], v1[3])};
                        if (kind == 0 && t >= LP - 3) { float* op = out + OFF_PC + ((size_t)(l * NB + b) * 3 + (t - (LP - 3))) * 512 + col; *(f32x4*)op = v0; *(f32x4*)(op + 4) = v1; }
                        if (kind == 1 && t >= 1) { float* op = out + OFF_SC + ((size_t)(l * SB + b) * 3 + (t - 1)) * 512 + col; *(f32x4*)op = v0; *(f32x4*)(op + 4) = v1; } }
                } else {
#pragma unroll
                    for (int bj = 0; bj < 2; ++bj) { const f32x4 v0 = acc[ai][bj][m][0] * rs, v1 = acc[ai][bj][m][1] * rs; const int col = 256 * (u.pn - 5) + 128 * bj + 32 * wc + 8 * fq;
                        *(u32x4*)(G + (long)row * 512 + col + (u.pm >= 64 ? G_DELTA : 0)) = (u32x4){cvt_pk_bf16(gelu_tanh(v0[0]), gelu_tanh(v0[1])), cvt_pk_bf16(gelu_tanh(v0[2]), gelu_tanh(v0[3])), cvt_pk_bf16(gelu_tanh(v1[0]), gelu_tanh(v1[1])), cvt_pk_bf16(gelu_tanh(v1[2]), gelu_tanh(v1[3]))}; }
                }
            }
    }
};
struct EpiGU {
    static constexpr bool PERM = true, AFTER_DRAIN = false;
    const float* xss; bf16_t* hact;
    __device__ __forceinline__ void operator()(const f32x4 (&acc)[2][2][4][2], const Unit& u, int wr, int wc, int fr, int fq) const {
        float rsv[2][4];
#pragma unroll
        for (int ai = 0; ai < 2; ++ai)
#pragma unroll
            for (int m = 0; m < 4; ++m) rsv[ai][m] = row_rs(xss, u.pm * BM + ai * HALF + wr * 64 + m * 16 + fr);
#pragma unroll
        for (int ai = 0; ai < 2; ++ai)
#pragma unroll
            for (int m = 0; m < 4; ++m) {
                const int row = u.pm * BM + ai * HALF + wr * 64 + m * 16 + fr; const float rs = rsv[ai][m];
                float h[8];
#pragma unroll
                for (int n = 0; n < 2; ++n)
#pragma unroll
                    for (int j = 0; j < 4; ++j) { const float g = acc[ai][0][m][n][j] * rs, uu = acc[ai][1][m][n][j] * rs; h[4 * n + j] = g * __builtin_amdgcn_rcpf(1.f + __expf(-g)) * uu; }
                { const u32x4 hv4 = (u32x4){cvt_pk_bf16(h[0], h[1]), cvt_pk_bf16(h[2], h[3]), cvt_pk_bf16(h[4], h[5]), cvt_pk_bf16(h[6], h[7])}; bf16_t* hp = hact + (size_t)row * D_FF + 128 * u.pn + 32 * wc + 8 * fq;
                    if (u.pm >= 64) asm volatile("global_store_dwordx4 %0, %1, off sc1\n\ts_nop 1" :: "v"(hp), "v"(hv4) : "memory");
                    else *(u32x4*)hp = hv4; }
            }
    }
};
struct EpiRes {
    static constexpr bool PERM = true, AFTER_DRAIN = true;
    float* out; int final_; bf16_t* xb16; float* xss; const float* gain; unsigned* xbuf; unsigned* cnt; unsigned* ready; unsigned* gdone; const unsigned* xcc_of;
    __device__ __forceinline__ void fused(f32x4 (&acc)[2][2][4][2], const Unit& u, int wr, int wc, int fr, int fq, PG8_LAS unsigned char* lds, int wid, int lane) const {
        PG8_LAS float* P = (PG8_LAS float*)lds;
        PG8_LAS float* S = (PG8_LAS float*)(lds + 4096);
        PG8_LAS float* P2 = (PG8_LAS float*)(lds + 8192);
        const int col0 = u.pn * BM + wc * 32 + 8 * fq;
        u32x4 pre[2][4][2];
#pragma unroll
        for (int ai = 0; ai < 2; ++ai)
#pragma unroll
            for (int m = 0; m < 4; ++m) { const bf16_t* br = xb16 + (size_t)(u.pm * BM + ai * HALF + wr * 64 + m * 16 + fr) * DM + col0;
#pragma unroll
                for (int bj = 0; bj < 2; ++bj) pre[ai][m][bj] = *(const u32x4*)(br + bj * HALF); }
#pragma unroll
        for (int ai = 0; ai < 2; ++ai)
#pragma unroll
            for (int m = 0; m < 4; ++m) { float s = 0.f;
#pragma unroll
                for (int bj = 0; bj < 2; ++bj)
#pragma unroll
                    for (int n = 0; n < 2; ++n) { const f32x4 x = acc[ai][bj][m][n]; s += (x[0] * x[0] + x[1] * x[1]) + (x[2] * x[2] + x[3] * x[3]); }
                s += __shfl_xor(s, 16); s += __shfl_xor(s, 32);
                if (fq == 0) P[(ai * HALF + wr * 64 + m * 16 + fr) * 4 + wc] = s; }
        asm volatile("s_waitcnt lgkmcnt(0)" ::: "memory"); __builtin_amdgcn_s_barrier(); asm volatile("" ::: "memory");
        const int row = wid * 32 + (lane & 31);
        if (lane < 32) { const float tot = (P[row * 4 + 0] + P[row * 4 + 1]) + (P[row * 4 + 2] + P[row * 4 + 3]);
            __hip_atomic_store(xbuf + ((size_t)(u.pm * BM + row) * 4 + u.pn), __float_as_uint(tot), __ATOMIC_RELAXED, __HIP_MEMORY_SCOPE_AGENT); }
        asm volatile("s_waitcnt vmcnt(0)" ::: "memory");
        if (lane == 0) __hip_atomic_fetch_add(cnt + 64 * u.pm, 1u, __ATOMIC_RELAXED, __HIP_MEMORY_SCOPE_AGENT);
        if (wid == 0) { unsigned spins = 0;
            for (;;) { if ((unsigned)__builtin_amdgcn_readfirstlane(__hip_atomic_load(cnt + 64 * u.pm, __ATOMIC_RELAXED, __HIP_MEMORY_SCOPE_AGENT)) >= 32u) break;
                if (++spins > (1u << 22)) break; __builtin_amdgcn_s_sleep(2); } }
        asm volatile("s_waitcnt vmcnt(0) lgkmcnt(0)" ::: "memory"); __builtin_amdgcn_s_barrier(); asm volatile("" ::: "memory");
        if (lane < 32) { const unsigned* sl = xbuf + (size_t)(u.pm * BM + row) * 4; float t = 0.f;
#pragma unroll
            for (int k = 0; k < 4; ++k) t += __uint_as_float(__hip_atomic_load(sl + k, __ATOMIC_RELAXED, __HIP_MEMORY_SCOPE_AGENT));
            S[row] = rsqrtf(t * (1.0f / 1024.0f) + EPS); }
        asm volatile("s_waitcnt lgkmcnt(0)" ::: "memory"); __builtin_amdgcn_s_barrier(); asm volatile("" ::: "memory");
        f32x4 gv[2][2];
#pragma unroll
        for (int bj = 0; bj < 2; ++bj)
#pragma unroll
            for (int n = 0; n < 2; ++n) gv[bj][n] = *(const f32x4*)(gain + col0 + bj * HALF + n * 4);
#pragma unroll
        for (int ai = 0; ai < 2; ++ai)
#pragma unroll
            for (int m = 0; m < 4; ++m) { const int r = ai * HALF + wr * 64 + m * 16 + fr, grow = u.pm * BM + r; const float rstd = S[r];
                bf16_t* br = xb16 + (size_t)grow * DM; float ss = 0.f;
                float* yr = nullptr;
                if (final_) { if (grow < MP) { const int b = grow / LP, t = grow - b * LP; if (t >= NMETA) yr = out + OFF_YP + ((size_t)b * SEQ + (t - NMETA)) * DM; } else if (grow < MV) yr = out + OFF_YS + (size_t)(grow - MP) * DM; }
#pragma unroll
                for (int bj = 0; bj < 2; ++bj) { const int c = col0 + bj * HALF; const u32x4 pb = pre[ai][m][bj];
                    const f32x4 o0 = (f32x4){bflo(pb.x), bfhi(pb.x), bflo(pb.y), bfhi(pb.y)} + acc[ai][bj][m][0] * rstd * gv[bj][0], o1 = (f32x4){bflo(pb.z), bfhi(pb.z), bflo(pb.w), bfhi(pb.w)} + acc[ai][bj][m][1] * rstd * gv[bj][1];
                    if (yr) { *(f32x4*)(yr + c) = o0; *(f32x4*)(yr + c + 4) = o1; }
                    if (!final_) *(u32x4*)(br + c) = (u32x4){cvt_pk_bf16(o0[0], o0[1]), cvt_pk_bf16(o0[2], o0[3]), cvt_pk_bf16(o1[0], o1[1]), cvt_pk_bf16(o1[2], o1[3])};
                    ss += ((o0[0] * o0[0] + o0[1] * o0[1]) + (o0[2] * o0[2] + o0[3] * o0[3])) + ((o1[0] * o1[0] + o1[1] * o1[1]) + (o1[2] * o1[2] + o1[3] * o1[3])); }
                ss += __shfl_xor(ss, 16); ss += __shfl_xor(ss, 32);
                if (fq == 0) P2[r * 4 + wc] = ss; }
        asm volatile("s_waitcnt lgkmcnt(0)" ::: "memory"); __builtin_amdgcn_s_barrier(); asm volatile("" ::: "memory");
        if (lane < 32 && !final_) xss[(size_t)(u.pm * BM + row) * 4 + u.pn] = (P2[row * 4 + 0] + P2[row * 4 + 1]) + (P2[row * 4 + 2] + P2[row * 4 + 3]);
        asm volatile("s_waitcnt vmcnt(0)" ::: "memory"); __builtin_amdgcn_s_barrier(); asm volatile("" ::: "memory");
        if (wid == 0) {
            bool flush = u.pm >= 64 && !final_;
            if (!flush && !final_) { const unsigned my = ((unsigned)__builtin_amdgcn_s_getreg((3 << 11) | 20) & 0xFu) + 1u;
                const unsigned v = lane < 32 ? __hip_atomic_load(xcc_of + 32 * (u.pm >> 3) + lane, __ATOMIC_RELAXED, __HIP_MEMORY_SCOPE_AGENT) : my;
                flush = __builtin_amdgcn_ballot_w64(v != my) != 0ull; }
            if (flush) __builtin_amdgcn_fence(__ATOMIC_RELEASE, "agent");
            asm volatile("s_waitcnt vmcnt(0)" ::: "memory");
            if (lane == 0) { if (u.pm < 64) __hip_atomic_fetch_add(gdone + 64 * ((unsigned)__builtin_amdgcn_s_getreg((3 << 11) | 20) & 0xFu), 8u, __ATOMIC_RELAXED, __HIP_MEMORY_SCOPE_AGENT); else __hip_atomic_fetch_add(ready + 64 * u.pm, 8u, __ATOMIC_RELAXED, __HIP_MEMORY_SCOPE_AGENT); } }
    }
};
__device__ __forceinline__ int tail_owner(int vcu) { const int x = vcu >> 5, j = vcu & 31; return j == 24 ? x : (j == 25 && x < 4) ? 8 + x : -1; }
struct PanelOrder {
    int vcu, round; const unsigned* gcnt;
    __device__ __forceinline__ bool next(int i, Unit& u) const { if (i > 0) return false; if (round == 0) { u.pm = vcu >> 2; u.pn = vcu & 3; return true; }
        const int tu = tail_owner(vcu); if (tu < 0) return false; u.pm = 64 + (tu >> 2); u.pn = tu & 3; return true; }
    __device__ __forceinline__ void a_ready(const Unit& u) const {
        if (gcnt) { if (threadIdx.x < 64) { unsigned polls = 0;
                for (;;) { const unsigned v = (threadIdx.x < 8) ? __hip_atomic_load(gcnt + 64 * threadIdx.x, __ATOMIC_RELAXED, __HIP_MEMORY_SCOPE_AGENT) : 32u;
                    const bool ok = (u.pm < 64) ? ((unsigned)__builtin_amdgcn_readlane((int)v, (vcu >> 5) & 7) >= 32u) : (__builtin_amdgcn_ballot_w64(v < 32u) == 0ull);
                    if (ok) break; if (++polls > (1u << 22)) break; __builtin_amdgcn_s_sleep(2); }
                __builtin_amdgcn_fence(__ATOMIC_ACQUIRE, "agent");
                asm volatile("s_waitcnt vmcnt(0)" ::: "memory"); }
            asm volatile("" ::: "memory"); __builtin_amdgcn_s_barrier(); asm volatile("" ::: "memory"); }
    }
    __device__ __forceinline__ void done(const Unit&) const {}
};
struct GatedOrder {
    int vcu, nN, skip_t; const unsigned* ready; const unsigned* gdone; unsigned need; mutable int waited;
    __device__ __forceinline__ bool next(int i, Unit& u) const {
        const int x = vcu >> 5, j = vcu & 31, nr = (nN + 3) >> 2, tu = tail_owner(vcu);
        if (skip_t == 1 && tu >= 0) return false;
        if (skip_t == 2 && tu >= 0 && i >= nr - 2) return false;
        if (i >= nr) return false;
        const int pn = 4 * i + (j >> 3);
        if (pn < nN) { u.pm = 8 * x + (j & 7); u.pn = pn; return true; }
        if (tu >= 0) return false;
        const int nfree_per = 32 - 8 * (nN & 3), f0 = 32 - nfree_per, nT = x < 4 ? 2 : 1;
        const int lidx = (j - f0) - (j > 24 ? 1 : 0) - ((x < 4 && j > 25) ? 1 : 0);
        if (skip_t && lidx < nT) { u.pm = 8 * x + lidx; u.pn = (skip_t == 2 ? 4 * (nr - 2) : 0) + 3; return true; }
        const int sk = skip_t ? 1 : 0, xm = x < 4 ? x : 4;
        const int t = x * nfree_per - (1 + sk) * (x + xm) + lidx - (skip_t ? nT : 0);
        if (t < 3 * nN) { u.pm = 64 + t / nN; u.pn = t % nN; return true; }
        return false;
    }
    __device__ __forceinline__ void a_ready(const Unit& u) const {
        if (need && (!waited || u.pm >= 64)) { waited = 1; if (threadIdx.x < 64) { unsigned polls = 0;
                for (;;) { unsigned v = (threadIdx.x < 16) ? __hip_atomic_load(gdone + 64 * threadIdx.x, __ATOMIC_RELAXED, __HIP_MEMORY_SCOPE_AGENT) : 0u;
                    v += (unsigned)__builtin_amdgcn_update_dpp(0, (int)v, 0x111, 0xf, 0xf, true); v += (unsigned)__builtin_amdgcn_update_dpp(0, (int)v, 0x112, 0xf, 0xf, true); v += (unsigned)__builtin_amdgcn_update_dpp(0, (int)v, 0x114, 0xf, 0xf, true); v += (unsigned)__builtin_amdgcn_update_dpp(0, (int)v, 0x118, 0xf, 0xf, true);
                    if ((unsigned)__builtin_amdgcn_readlane((int)v, 15) >= 2048u) break; if (++polls > (1u << 22)) break; __builtin_amdgcn_s_sleep(2); }
                if (u.pm >= 64) { while ((unsigned)__builtin_amdgcn_readfirstlane(__hip_atomic_load(ready + 64 * u.pm, __ATOMIC_RELAXED, __HIP_MEMORY_SCOPE_AGENT)) < need) { if (++polls > (1u << 22)) break; __builtin_amdgcn_s_sleep(2); } }
                __builtin_amdgcn_fence(__ATOMIC_ACQUIRE, "agent");
                asm volatile("s_waitcnt vmcnt(0)" ::: "memory"); }
            asm volatile("" ::: "memory"); __builtin_amdgcn_s_barrier(); asm volatile("" ::: "memory"); }
    }
    __device__ __forceinline__ void done(const Unit&) const {}
};
template <class Epi, class Sched, bool ALIGN_EPI = false, bool SP2 = false>
__device__ __forceinline__ void gemm_phase(PG8_LAS unsigned char* lds, const Gemm g, const Sched& S, const Epi& E) {
    int tid_ = threadIdx.x; asm volatile("" : "+v"(tid_));
    const int tid = tid_, wid = __builtin_amdgcn_readfirstlane(tid >> 6), lane = tid & 63, wr = wid >> 2, wc = wid & 3, fr = lane & 15, fq = lane >> 4;
    const int K = g.K, nt = K / BK;
    unsigned voffA[2], voffB[2];
#pragma unroll
    for (int i = 0; i < 2; ++i) { int R, C; stage_rc(tid * 16 + i * 8192, R, C); const int Rb = Epi::PERM ? ((R & ~31) + perm32(R & 31)) : R;
        voffA[i] = (unsigned)(R * K + C) * 2u; voffB[i] = (unsigned)(Rb * K + C) * 2u; }
    const size_t kstep = (size_t)(BK * 2);
    const size_t hstep = (size_t)HALF * K * 2;
    const size_t tstep = 2 * hstep;
    const unsigned ldsw = (unsigned)wid * 1024u;
    const int aoff = lds_byte(wr * 64 + fr, fq * 8), boff = lds_byte(wc * 32 + fr, fq * 8);
#define PG8_SA(b, h) (((b) * 2 + (h)) * HTB)
#define PG8_SB(b, h) ((4 + (b) * 2 + (h)) * HTB)
#define PG8_STAGE(bufoff, gbase, voff) do { _Pragma("unroll") for (int _i = 0; _i < 2; ++_i) \
        __builtin_amdgcn_global_load_lds((const unsigned*)((const char*)(gbase) + (voff)[_i]), (PG8_LAS unsigned*)(lds + (bufoff) + ldsw + _i * 8192), 16, 0, 0); } while (0)
#define PG8_LDA(dst, b, h) do { _Pragma("unroll") for (int m = 0; m < 4; ++m) _Pragma("unroll") for (int k = 0; k < 2; ++k) dst[m][k] = *(const PG8_LAS bf16x8*)(lds + PG8_SA(b, h) + aoff + m * 2048 + k * 1024); } while (0)
#define PG8_LDB(dst, b, h) do { _Pragma("unroll") for (int n = 0; n < 2; ++n) _Pragma("unroll") for (int k = 0; k < 2; ++k) dst[n][k] = *(const PG8_LAS bf16x8*)(lds + PG8_SB(b, h) + boff + n * 2048 + k * 1024); } while (0)
#define PG8_MMA(ai, bj, At, Bt) do { __builtin_amdgcn_s_setprio(1); _Pragma("unroll") for (int m = 0; m < 4; ++m) _Pragma("unroll") for (int n = 0; n < 2; ++n) _Pragma("unroll") for (int k = 0; k < 2; ++k) \
        acc[ai][bj][m][n] = __builtin_amdgcn_mfma_f32_16x16x32_bf16(Bt[n][k], At[m][k], acc[ai][bj][m][n], 0, 0, 0); __builtin_amdgcn_s_setprio(0); } while (0)
#define PG8_WAIT_V(n) asm volatile("s_waitcnt vmcnt(" #n ")" ::: "memory")
#define PG8_WAIT_L(n) asm volatile("s_waitcnt lgkmcnt(" #n ")" ::: "memory")
#define PG8_BAR __builtin_amdgcn_s_barrier()
#define PG8_SCHED __builtin_amdgcn_sched_barrier(0)
    Unit cur, nxt; int ui = 0;
    if (!S.next(0, cur)) return;
    f32x4 acc[2][2][4][2];
#pragma unroll
    for (int a = 0; a < 2; ++a)
#pragma unroll
        for (int b = 0; b < 2; ++b)
#pragma unroll
            for (int m = 0; m < 4; ++m)
#pragma unroll
                for (int n = 0; n < 2; ++n) acc[a][b][m][n] = (f32x4){0.f, 0.f, 0.f, 0.f};
    bf16x8 At[4][2], B0[2][2], B1[2][2];
    const char* cA = (const char*)g.A + (size_t)cur.pm * tstep; const char* cB = (const char*)g.Bt + (size_t)cur.pn * tstep;
    S.a_ready(cur);
    if constexpr (SP2) {
        PG8_STAGE(PG8_SB(0, 0), cB, voffB); PG8_STAGE(PG8_SB(0, 1), cB + hstep, voffB); PG8_STAGE(PG8_SA(0, 0), cA, voffA); PG8_STAGE(PG8_SA(0, 1), cA + hstep, voffA);
        if (wr == 1) PG8_BAR;
        PG8_WAIT_V(2); PG8_BAR;
        PG8_STAGE(PG8_SB(1, 0), cB + kstep, voffB); PG8_STAGE(PG8_SA(1, 0), cA + kstep, voffA); PG8_STAGE(PG8_SB(1, 1), cB + hstep + kstep, voffB);
        PG8_WAIT_V(6); PG8_BAR;
    } else {
        PG8_STAGE(PG8_SB(0, 0), cB, voffB); PG8_STAGE(PG8_SA(0, 0), cA, voffA); PG8_STAGE(PG8_SB(0, 1), cB + hstep, voffB); PG8_STAGE(PG8_SA(0, 1), cA + hstep, voffA);
        if (wr == 1) PG8_BAR;
        PG8_WAIT_V(4); PG8_BAR;
        PG8_STAGE(PG8_SB(1, 0), cB + kstep, voffB); PG8_STAGE(PG8_SA(1, 0), cA + kstep, voffA); PG8_STAGE(PG8_SB(1, 1), cB + hstep + kstep, voffB);
        PG8_WAIT_V(6); PG8_BAR;
    }
    for (;;) {
        const bool has_next = S.next(ui + 1, nxt);
        const char* nA = has_next ? (const char*)g.A + (size_t)nxt.pm * tstep : cA; const char* nB = has_next ? (const char*)g.Bt + (size_t)nxt.pn * tstep : cB;
        for (int t = 0; t < nt; t += 2) {
            const bool last = (t == nt - 2);
            const char* a1 = cA + (size_t)(t + 1) * kstep;
            const char* a2 = last ? nA : cA + (size_t)(t + 2) * kstep; const char* b2 = last ? nB : cB + (size_t)(t + 2) * kstep;
            const char* a3 = a2 + kstep; const char* b3 = b2 + kstep;
            if (last && has_next) S.a_ready(nxt);
            if constexpr (SP2) {
            PG8_LDB(B0, 0, 0); PG8_LDB(B1, 0, 1); PG8_SCHED; PG8_LDA(At, 0, 0); PG8_STAGE(PG8_SA(1, 1), a1 + hstep, voffA);
            PG8_WAIT_V(8); PG8_WAIT_L(0); PG8_BAR; PG8_MMA(0, 0, At, B0); PG8_MMA(0, 1, At, B1); PG8_BAR; PG8_SCHED;
            PG8_LDA(At, 0, 1); PG8_STAGE(PG8_SB(0, 0), b2, voffB); PG8_STAGE(PG8_SB(0, 1), b2 + hstep, voffB); PG8_STAGE(PG8_SA(0, 0), a2, voffA);
            PG8_WAIT_V(8); PG8_WAIT_L(0); PG8_BAR; PG8_MMA(1, 0, At, B0); PG8_MMA(1, 1, At, B1); PG8_BAR; PG8_SCHED;
            PG8_LDB(B0, 1, 0); PG8_LDB(B1, 1, 1); PG8_SCHED; PG8_LDA(At, 1, 0); PG8_STAGE(PG8_SA(0, 1), a2 + hstep, voffA);
            PG8_WAIT_V(8); PG8_WAIT_L(0); PG8_BAR; PG8_MMA(0, 0, At, B0); PG8_MMA(0, 1, At, B1); PG8_BAR; PG8_SCHED;
            PG8_LDA(At, 1, 1); PG8_STAGE(PG8_SB(1, 0), b3, voffB); PG8_STAGE(PG8_SB(1, 1), b3 + hstep, voffB); PG8_STAGE(PG8_SA(1, 0), a3, voffA);
            PG8_WAIT_V(8); PG8_WAIT_L(0); PG8_BAR; PG8_MMA(1, 0, At, B0); PG8_MMA(1, 1, At, B1); PG8_BAR; PG8_SCHED;
            } else {
            PG8_LDB(B0, 0, 0); PG8_SCHED; PG8_LDA(At, 0, 0); PG8_STAGE(PG8_SA(1, 1), a1 + hstep, voffA);
            PG8_WAIT_L(8); PG8_BAR; PG8_WAIT_L(0); PG8_MMA(0, 0, At, B0); PG8_BAR; PG8_SCHED;
            PG8_LDB(B1, 0, 1); PG8_STAGE(PG8_SB(0, 0), b2, voffB);
            PG8_BAR; PG8_WAIT_L(0); PG8_MMA(0, 1, At, B1); PG8_BAR;
            PG8_LDA(At, 0, 1); PG8_STAGE(PG8_SA(0, 0), a2, voffA);
            PG8_BAR; PG8_WAIT_L(0); PG8_MMA(1, 0, At, B0); PG8_BAR; PG8_SCHED;
            PG8_STAGE(PG8_SB(0, 1), b2 + hstep, voffB);
            PG8_WAIT_V(6); PG8_BAR; PG8_MMA(1, 1, At, B1); PG8_BAR;
            PG8_LDB(B0, 1, 0); PG8_SCHED; PG8_LDA(At, 1, 0); PG8_STAGE(PG8_SA(0, 1), a2 + hstep, voffA);
            PG8_WAIT_L(8); PG8_BAR; PG8_WAIT_L(0); PG8_MMA(0, 0, At, B0); PG8_BAR; PG8_SCHED;
            PG8_LDB(B1, 1, 1); PG8_STAGE(PG8_SB(1, 0), b3, voffB);
            PG8_BAR; PG8_WAIT_L(0); PG8_MMA(0, 1, At, B1); PG8_BAR;
            PG8_LDA(At, 1, 1); PG8_STAGE(PG8_SA(1, 0), a3, voffA);
            PG8_BAR; PG8_WAIT_L(0); PG8_MMA(1, 0, At, B0); PG8_BAR; PG8_SCHED;
            PG8_STAGE(PG8_SB(1, 1), b3 + hstep, voffB);
            PG8_WAIT_V(6); PG8_BAR; PG8_MMA(1, 1, At, B1); PG8_BAR;
            }
        }
        if constexpr (ALIGN_EPI) { if (wr == 0) PG8_BAR; }
        if constexpr (!Epi::AFTER_DRAIN) { E(acc, cur, wr, wc, fr, fq); S.done(cur); }
        if (!has_next) break;
#pragma unroll
        for (int a = 0; a < 2; ++a)
#pragma unroll
            for (int b = 0; b < 2; ++b)
#pragma unroll
                for (int m = 0; m < 4; ++m)
#pragma unroll
                    for (int n = 0; n < 2; ++n) acc[a][b][m][n] = (f32x4){0.f, 0.f, 0.f, 0.f};
        cur = nxt; cA = nA; cB = nB; ++ui;
        if constexpr (ALIGN_EPI) { if (wr == 1) PG8_BAR; }
    }
    PG8_WAIT_V(0);
    if constexpr (!ALIGN_EPI) { if (wr == 0) PG8_BAR; }
    PG8_BAR;
    if constexpr (Epi::AFTER_DRAIN) { E.fused(acc, cur, wr, wc, fr, fq, lds, wid, lane); S.done(cur); }
#undef PG8_SA
#undef PG8_SB
#undef PG8_STAGE
#undef PG8_LDA
#undef PG8_LDB
#undef PG8_MMA
#undef PG8_WAIT_V
#undef PG8_WAIT_L
#undef PG8_BAR
#undef PG8_SCHED
}
}
constexpr int NWAVES = 8, NTHREADS = 512, LDS_BYTES = 131072 + 20480;
struct Args { const float* in[26]; float* out; unsigned char* ws; };
struct Ctx {
    unsigned char* lds;
    int tid, lane, wave, vcu, gw;
};
#define OPQ_PTRS unsigned long long ws_i_ = (unsigned long long)A.ws, out_i_ = (unsigned long long)A.out; asm volatile("" : "+s"(ws_i_), "+s"(out_i_)); unsigned char* ws = (unsigned char*)(__attribute__((address_space(1))) unsigned char*)ws_i_; float* out = (float*)(__attribute__((address_space(1))) float*)out_i_
#define IN_XP 0
#define IN_XS 1
#define IN_CK 2
#define IN_CV 3
#define IN_SH 4
#define IN_SC 5
#define IN_META 6
#define IN_PREMIX 7
#define IN_WIN 8
#define IN_SINK 9
#define IN_CONVW 10
#define IN_CONVB 11
#define IN_WA 12
#define IN_BA 13
#define IN_WI 14
#define IN_BI 15
#define IN_LAM 16
#define IN_ATTN_G 17
#define IN_LRU_G 18
#define IN_WOUT 19
#define IN_POSTMIX 20
#define IN_PREFFN 21
#define IN_WGATE 22
#define IN_WUP 23
#define IN_WDOWN 24
#define IN_POSTFFN 25

__device__ __forceinline__ int dest_row(int mode, int c) {
    if (mode == 1) { if (c >= 640) return c; const int d = c & 63, n = d >> 5, w = (d >> 4) & 1, fq = 2 * ((d >> 2) & 1) + ((d >> 3) & 1), j = d & 3; return (c & ~63) + 32 * w + 8 * fq + 4 * n + j; }
    if (mode == 2) return 256 * (c >> 7) + (c & 127);
    if (mode == 3) return 256 * (c >> 7) + 128 + (c & 127);
    return c;
}
__device__ __forceinline__ void transpose_item(const float* W, int K, int N, bf16_t* WT, int mode, const float* g1, const float* g2, float* scr, int item, int lane) {
    const int nblk = N / 32, kb = item / nblk, nb = item % nblk, k0 = 64 * kb, n0 = 32 * nb;
    float wv[32];
#pragma unroll
    for (int i = 0; i < 32; ++i) { const int kk = 2 * i + (lane >> 5); wv[i] = W[(size_t)(k0 + kk) * N + n0 + (lane & 31)]; }
    if (g1) {
#pragma unroll
        for (int i = 0; i < 32; ++i) { const int k = k0 + 2 * i + (lane >> 5); wv[i] *= (k < 512 || !g2) ? g1[k] : g2[k - 512]; } }
#pragma unroll
    for (int i = 0; i < 32; ++i) { const int kk = 2 * i + (lane >> 5); scr[kk * 33 + (lane & 31)] = wv[i]; }
    asm volatile("s_waitcnt lgkmcnt(0)" ::: "memory");
    const int c = lane & 7;
#pragma unroll
    for (int j = 0; j < 4; ++j) { const int n = (lane >> 3) + 8 * j; const float* s = scr + (8 * c) * 33 + n;
        u32x4 o; o.x = cvt_pk_bf16(s[0 * 33], s[1 * 33]); o.y = cvt_pk_bf16(s[2 * 33], s[3 * 33]); o.z = cvt_pk_bf16(s[4 * 33], s[5 * 33]); o.w = cvt_pk_bf16(s[6 * 33], s[7 * 33]);
        *(u32x4*)(WT + (size_t)dest_row(mode, n0 + n) * K + k0 + 8 * c) = o; }
    asm volatile("s_waitcnt lgkmcnt(0)" ::: "memory");
}
__device__ __forceinline__ void p0_prologue(const Args& A, Ctx& C) {
    OPQ_PTRS;
    float* scr = (float*)(C.lds + C.wave * 8448);
    const int NGW = 256 * NWAVES;
    constexpr int I_IN = 16 * 56, I_OUT = 16 * 32, I_G = 16 * 88, I_D = 44 * 32, I_LAYER = I_IN + I_OUT + 2 * I_G + I_D;
    for (int it = C.gw; it < DEPTH * I_LAYER; it += NGW) {
        const int l = it / I_LAYER; int r = it - l * I_LAYER;
        unsigned char* wb = ws + WS_W + (size_t)l * W_LAYER_B;
        if (r < I_IN) { transpose_item(A.in[IN_WIN] + (size_t)l * DM * IN_W, DM, IN_W, (bf16_t*)wb, 1, A.in[IN_PREMIX] + l * DM, nullptr, scr, r, C.lane); continue; } r -= I_IN;
        if (r < I_OUT) { transpose_item(A.in[IN_WOUT] + (size_t)l * DM * DM, DM, DM, (bf16_t*)(wb + W_IN_B), 0, A.in[IN_ATTN_G] + l * 512, A.in[IN_LRU_G] + l * 512, scr, r, C.lane); continue; } r -= I_OUT;
        if (r < I_G) { transpose_item(A.in[IN_WGATE] + (size_t)l * DM * D_FF, DM, D_FF, (bf16_t*)(wb + W_IN_B + W_OUT_B), 2, A.in[IN_PREFFN] + l * DM, nullptr, scr, r, C.lane); continue; } r -= I_G;
        if (r < I_G) { transpose_item(A.in[IN_WUP] + (size_t)l * DM * D_FF, DM, D_FF, (bf16_t*)(wb + W_IN_B + W_OUT_B), 3, A.in[IN_PREFFN] + l * DM, nullptr, scr, r, C.lane); continue; } r -= I_G;
        transpose_item(A.in[IN_WDOWN] + (size_t)l * D_FF * DM, D_FF, DM, (bf16_t*)(wb + W_IN_B + W_OUT_B + W_GU_B), 0, nullptr, nullptr, scr, r, C.lane);
    }
    float* xmeta = (float*)(ws + WS_XMETA); bf16_t* xb16 = (bf16_t*)(ws + WS_XB16); float* xss = (float*)(ws + WS_XSS);
    for (int row0 = C.gw; row0 < MPAD; row0 += 4 * NGW) {
        f32x4 v[4][4]; bool ok[4];
#pragma unroll
        for (int q = 0; q < 4; ++q) { const int row = row0 + q * NGW; ok[q] = row < MPAD; const float* src = nullptr;
            if (row < MP) { const int b = row / LP, t = row - b * LP; src = t < NMETA ? A.in[IN_META] + (size_t)t * DM : A.in[IN_XP] + ((size_t)b * SEQ + (t - NMETA)) * DM; }
            else if (row < MV) src = A.in[IN_XS] + (size_t)(row - MP) * DM;
#pragma unroll
            for (int j = 0; j < 4; ++j) v[q][j] = src ? *((const f32x4*)src + C.lane + 64 * j) : (f32x4){0.f, 0.f, 0.f, 0.f}; }
        float sq[4];
#pragma unroll
        for (int q = 0; q < 4; ++q) { sq[q] = 0.f;
#pragma unroll
            for (int j = 0; j < 4; ++j) { const f32x4 x = v[q][j]; sq[q] += (x[0] * x[0] + x[1] * x[1]) + (x[2] * x[2] + x[3] * x[3]); } }
#pragma unroll
        for (int o = 1; o < 64; o <<= 1) {
#pragma unroll
            for (int q = 0; q < 4; ++q) sq[q] += __shfl_xor(sq[q], o); }
#pragma unroll
        for (int q = 0; q < 4; ++q) { if (!ok[q]) continue; const int row = row0 + q * NGW;
#pragma unroll
            for (int j = 0; j < 4; ++j) *((u32x2*)(xb16 + (size_t)row * DM) + C.lane + 64 * j) = (u32x2){cvt_pk_bf16(v[q][j][0], v[q][j][1]), cvt_pk_bf16(v[q][j][2], v[q][j][3])};
            if (C.lane < 4) xss[(size_t)row * 4 + C.lane] = C.lane == 0 ? sq[q] : 0.f; }
    }
    bf16_t* kS = (bf16_t*)(ws + WS_KS); bf16_t* vTS = (bf16_t*)(ws + WS_VTS);
    bf16_t* vl = (bf16_t*)C.lds;
    for (int lb = C.vcu; lb < DEPTH * SB; lb += 256) {
        __syncthreads();
        const f32x4* ksrc = (const f32x4*)(A.in[IN_CK] + (size_t)lb * 16384); const f32x4* vsrc = (const f32x4*)(A.in[IN_CV] + (size_t)lb * 16384);
        f32x4 kv[8], vv[8];
#pragma unroll
        for (int i = 0; i < 8; ++i) { kv[i] = ksrc[i * 512 + C.tid]; vv[i] = vsrc[i * 512 + C.tid]; }
#pragma unroll
        for (int i = 0; i < 8; ++i) { const int idx = i * 512 + C.tid, j = idx >> 5, c4 = (idx & 31) * 4;
            *(u32x2*)(kS + ((size_t)lb * KS_ROWS + j) * 128 + c4) = (u32x2){cvt_pk_bf16(kv[i][0], kv[i][1]), cvt_pk_bf16(kv[i][2], kv[i][3])};
            const unsigned w0 = cvt_pk_bf16(vv[i][0], vv[i][1]), w1 = cvt_pk_bf16(vv[i][2], vv[i][3]);
            vl[(c4 + 0) * 136 + j] = (bf16_t)(w0 & 0xffffu); vl[(c4 + 1) * 136 + j] = (bf16_t)(w0 >> 16); vl[(c4 + 2) * 136 + j] = (bf16_t)(w1 & 0xffffu); vl[(c4 + 3) * 136 + j] = (bf16_t)(w1 >> 16);
            if (j >= 4) { *(f32x4*)(out + OFF_SK + ((size_t)lb * 128 + j - 4) * 128 + c4) = kv[i]; *(f32x4*)(out + OFF_SV + ((size_t)lb * 128 + j - 4) * 128 + c4) = vv[i]; } }
        __syncthreads();
#pragma unroll
        for (int i = 0; i < 4; ++i) { const int idx = i * 512 + C.tid, c = idx >> 4, j8 = (idx & 15) * 8;
            *(u32x4*)(vTS + ((size_t)lb * 128 + c) * VTS_LD + j8) = *(const u32x4*)(vl + c * 136 + j8); }
    }
    __syncthreads();
    bf16_t* lw = (bf16_t*)(ws + WS_LRUW);
    for (int e = C.gw * 64 + C.lane; e < DEPTH * 8 * 4096; e += NGW * 64) {
        const int i = e & 63, j = (e >> 6) & 63, lh = e >> 12;
        lw[e] = (bf16_t)(cvt_pk_bf16(A.in[IN_WA][(size_t)lh * 4096 + i * 64 + j], 0.f) & 0xffffu);
        lw[DEPTH * 8 * 4096 + e] = (bf16_t)(cvt_pk_bf16(A.in[IN_WI][(size_t)lh * 4096 + i * 64 + j], 0.f) & 0xffffu);
    }
}
#define XB_TMO      128
#define XB_XCNT(j)  (256  + 64 * (j))
#define XB_XSUB(j)  (1280 + 64 * (j))
#define XB_XGEN(j)  (2304 + 64 * (j))
#define XB_TOP      3328
#define XB_TOPGEN   3392
#define XCD_BAR_WORDS 3456
#define XB_SPIN_CAP (1u << 18)

__device__ __forceinline__ unsigned xb_ld(unsigned* p)              { return __hip_atomic_load(p, __ATOMIC_RELAXED, __HIP_MEMORY_SCOPE_AGENT); }
__device__ __forceinline__ unsigned xb_add(unsigned* p, unsigned v) { return __hip_atomic_fetch_add(p, v, __ATOMIC_RELAXED, __HIP_MEMORY_SCOPE_AGENT); }
__device__ __forceinline__ unsigned xb_xcc_id() { return (unsigned)__builtin_amdgcn_s_getreg((3 << 11) | 20) & 0xFu; }
#define XB_SPIN(cond, bar) do { unsigned _sp = 0; while (cond) { __builtin_amdgcn_s_sleep(1); \
    if ((++_sp & 255u) == 0u) { if (xb_ld(&(bar)[XB_TMO])) break; if (_sp > XB_SPIN_CAP) { atomicAdd(&(bar)[XB_TMO], 1u); break; } } } } while (0)

struct XcdBarrier {
    unsigned* bar; unsigned x;
    volatile __attribute__((address_space(3))) unsigned* st;
};

__device__ __forceinline__ XcdBarrier xcd_barrier_post(unsigned* bar, volatile __attribute__((address_space(3))) unsigned* st) {
    XcdBarrier b; b.bar = bar; b.x = xb_xcc_id(); b.st = st;
    if (threadIdx.x == 0) (void)xb_add(&bar[XB_XCNT(b.x)], 1u);
    return b;
}
__device__ __forceinline__ void xcd_barrier_complete(unsigned* bar, unsigned x, unsigned& nloc, unsigned& nx) {
    const unsigned G = gridDim.x * gridDim.y * gridDim.z;
    unsigned sum, cnt, mine, sp = 0u;
    for (;;) {
        sum = 0u; cnt = 0u; mine = 0u;
#pragma unroll
        for (unsigned j = 0; j < 16; ++j) { const unsigned c = xb_ld(&bar[XB_XCNT(j)]); sum += c; cnt += (c > 0u) ? 1u : 0u; mine = (j == x) ? c : mine; }
        if (sum == G) break;
        __builtin_amdgcn_s_sleep(1);
        if ((++sp & 255u) == 0u) { if (xb_ld(&bar[XB_TMO])) break; if (sp > XB_SPIN_CAP) { atomicAdd(&bar[XB_TMO], 1u); break; } }
    }
    nloc = mine > 0u ? mine : 1u; nx = cnt > 0u ? cnt : 1u;
}

__device__ __forceinline__ void xcd_barrier(const XcdBarrier& b) {
    asm volatile("s_waitcnt vmcnt(0)" ::: "memory");
    __syncthreads();
    if (threadIdx.x == 0) {
        unsigned* bar = b.bar;
        __builtin_amdgcn_s_waitcnt(0);
        unsigned nloc = b.st[0], nx = b.st[1];
        if (nloc == 0u) { xcd_barrier_complete(bar, b.x, nloc, nx); b.st[0] = nloc; b.st[1] = nx; }
        const unsigned old = xb_add(&bar[XB_XSUB(b.x)], 1u);
        const unsigned gen = old / nloc;
        if (old + 1u == (gen + 1u) * nloc) {
            __builtin_amdgcn_fence(__ATOMIC_RELEASE, "agent");
            asm volatile("s_waitcnt vmcnt(0)" ::: "memory");
            const unsigned og = xb_add(&bar[XB_TOP], 1u);
            const unsigned tg = og / nx;
            if (og + 1u == (tg + 1u) * nx) xb_add(&bar[XB_TOPGEN], 1u);
            else XB_SPIN(xb_ld(&bar[XB_TOPGEN]) == tg, bar);
            __builtin_amdgcn_fence(__ATOMIC_ACQUIRE, "agent");
            xb_add(&bar[XB_XGEN(b.x)], 1u);
            asm volatile("s_waitcnt vmcnt(0)" ::: "memory");
        } else {
            XB_SPIN(xb_ld(&bar[XB_XGEN(b.x)]) == gen, bar);
            __builtin_amdgcn_fence(__ATOMIC_ACQUIRE, "agent");
            asm volatile("s_waitcnt vmcnt(0)" ::: "memory");
        }
    }
    __syncthreads();
}
__device__ __forceinline__ void attn_item(const Args& A, Ctx& C, unsigned char* ws, float* out, int l, int it) {
    const int lane = C.lane, n = lane & 15, kq = lane >> 4;
    const bf16_t* Q = (const bf16_t*)(ws + WS_Q); bf16_t* O = (bf16_t*)(ws + WS_MRG);
    int tq, head, qrow, kt_hi, kstride_v; const bf16_t* Kb; const bf16_t* Vb;
    if (it < NB * 129 * 8) { const int h = it & 7, qt = (it >> 3) % 129, b = (it >> 3) / 129; tq = 16 * qt + n; head = h; qrow = b * LP + tq; kt_hi = qt;
        Kb = (const bf16_t*)(ws + WS_KP) + (size_t)b * LP * 128 + (h >> 2) * 64; Vb = (const bf16_t*)(ws + WS_VTP) + (size_t)(b * 2 + (h >> 2)) * 64 * VTP_LD; kstride_v = VTP_LD; }
    else { const int i2 = it - NB * 129 * 8, g = i2 & 1, bs = i2 >> 1; tq = 128 + (n & 3); head = 4 * g + (n >> 2); qrow = MP + bs * 4 + (n & 3); kt_hi = 8;
        Kb = (const bf16_t*)(ws + WS_KS) + (size_t)(l * SB + bs) * KS_ROWS * 128 + g * 64; Vb = (const bf16_t*)(ws + WS_VTS) + (size_t)((l * SB + bs) * 2 + g) * 64 * VTS_LD; kstride_v = VTS_LD; }
    const bf16x8 q0 = *(const bf16x8*)(Q + (size_t)qrow * 512 + head * 64 + 8 * kq), q1 = *(const bf16x8*)(Q + (size_t)qrow * 512 + head * 64 + 32 + 8 * kq);
    const float sink = A.in[IN_SINK][l * 8 + head];
    u32x2 vfa[5][4], vfb[5][4];
#pragma unroll
    for (int pr = 0; pr < 5; ++pr) { int kta = kt_hi - 8 + 2 * pr - 1, ktb = kt_hi - 8 + 2 * pr; kta = kta < 0 ? 0 : kta; ktb = ktb < 0 ? 0 : ktb;
#pragma unroll
        for (int dt = 0; dt < 4; ++dt) { const bf16_t* vp = Vb + (size_t)(16 * dt + n) * kstride_v + 4 * kq; vfa[pr][dt] = *(const u32x2*)(vp + 16 * kta); vfb[pr][dt] = *(const u32x2*)(vp + 16 * ktb); } }
    f32x4 s[9]; float mx = sink;
#pragma unroll
    for (int T = 0; T < 9; ++T) { const int kt = kt_hi - 8 + T; s[T] = (f32x4){0.f, 0.f, 0.f, 0.f};
        if (kt >= 0) { const bf16_t* kp = Kb + (size_t)(16 * kt + n) * 128 + 8 * kq; const bf16x8 k0 = *(const bf16x8*)kp, k1 = *(const bf16x8*)(kp + 32);
            s[T] = __builtin_amdgcn_mfma_f32_16x16x32_bf16(k0, q0, s[T], 0, 0, 0); s[T] = __builtin_amdgcn_mfma_f32_16x16x32_bf16(k1, q1, s[T], 0, 0, 0); }
#pragma unroll
        for (int j = 0; j < 4; ++j) { const int key = 16 * kt + 4 * kq + j; const bool ok = (key >= 0) && (key <= tq) && (key > tq - 128); s[T][j] = ok ? s[T][j] : -INFINITY; mx = fmaxf(mx, s[T][j]); } }
    mx = fmaxf(mx, __shfl_xor(mx, 16)); mx = fmaxf(mx, __shfl_xor(mx, 32));
    float sum = 0.f; u32x2 pk[9];
#pragma unroll
    for (int T = 0; T < 9; ++T) { float p[4];
#pragma unroll
        for (int j = 0; j < 4; ++j) { p[j] = __expf(s[T][j] - mx); sum += p[j]; }
        pk[T] = (u32x2){cvt_pk_bf16(p[0], p[1]), cvt_pk_bf16(p[2], p[3])}; }
    sum += __shfl_xor(sum, 16); sum += __shfl_xor(sum, 32);
    sum += __expf(sink - mx);
    const float rl = __builtin_amdgcn_rcpf(sum);
    f32x4 o[4];
#pragma unroll
    for (int dt = 0; dt < 4; ++dt) o[dt] = (f32x4){0.f, 0.f, 0.f, 0.f};
#pragma unroll
    for (int pr = 0; pr < 5; ++pr) { const int Ta = 2 * pr - 1, Tb = 2 * pr;
        const u32x2 pa = Ta >= 0 ? pk[Ta < 0 ? 0 : Ta] : (u32x2){0u, 0u}, pb = pk[Tb];
        const bf16x8 pf = __builtin_bit_cast(bf16x8, (u32x4){pa.x, pa.y, pb.x, pb.y});
#pragma unroll
        for (int dt = 0; dt < 4; ++dt) { const bf16x8 vf = __builtin_bit_cast(bf16x8, (u32x4){vfa[pr][dt].x, vfa[pr][dt].y, vfb[pr][dt].x, vfb[pr][dt].y});
            o[dt] = __builtin_amdgcn_mfma_f32_16x16x32_bf16(vf, pf, o[dt], 0, 0, 0); } }
#pragma unroll
    for (int dt = 0; dt < 4; ++dt) *(u32x2*)(O + (size_t)qrow * DM + head * 64 + 16 * dt + 4 * kq) = (u32x2){cvt_pk_bf16(o[dt][0] * rl, o[dt][1] * rl), cvt_pk_bf16(o[dt][2] * rl, o[dt][3] * rl)};
}
__device__ __forceinline__ void lru_item(const Args& A, Ctx& C, unsigned char* ws, float* out, int l, int it, const unsigned char* wl, const float* cwl) {
    const int lane = C.lane, fr = lane & 15, kq = lane >> 4;
    const bool samp = it >= NB * NCH * 8;
    int blk, b, c, rowbase;
    if (it < 2048) { blk = it & 7; c = (it >> 3) & 31; b = it >> 8; rowbase = b * LP + 64 * c; }
    else if (!samp) { blk = it & 7; c = NCH - 1; b = (it - 2048) >> 3; rowbase = b * LP + 64 * c; }
    else { const int i2 = it - NB * NCH * 8; blk = i2 & 7; c = i2 >> 3; b = 0; rowbase = MP + 16 * c; }
    const bf16_t* XBC = (const bf16_t*)(ws + WS_XBC); bf16_t* MRG = (bf16_t*)(ws + WS_MRG); bf16_t* PL = (bf16_t*)(ws + WS_PL);
    float ba[4], bi[4], lsl[4], h0v[4];
#pragma unroll
    for (int nt = 0; nt < 4; ++nt) { ba[nt] = cwl[320 + 16 * nt + fr]; bi[nt] = cwl[384 + 16 * nt + fr]; lsl[nt] = cwl[448 + 16 * nt + fr];
        h0v[nt] = samp ? A.in[IN_SH][(size_t)(l * SB + 4 * c + kq) * 512 + 64 * blk + 16 * nt + fr] : 0.f; }
    const float* cw = cwl; const float* cb = cwl + 256;
    float Pc[4], Hc[4];
#pragma unroll
    for (int nt = 0; nt < 4; ++nt) { Pc[nt] = 1.f; Hc[nt] = 0.f; }
    const int nvalid = samp ? 16 : (LP - 64 * c < 64 ? LP - 64 * c : 64);
    u32x4 xcur[2], xprev[2], xnext[2];
#pragma unroll
    for (int ks = 0; ks < 2; ++ks) { xcur[ks] = xprev[ks] = xnext[ks] = (u32x4){0u, 0u, 0u, 0u}; }
    if (!samp) {
#pragma unroll
        for (int ks = 0; ks < 2; ++ks) { const int tp = 64 * c - 16 + fr; if (tp >= 0) xprev[ks] = *(const u32x4*)(XBC + (size_t)(b * LP + tp) * 512 + 64 * blk + 32 * ks + 8 * kq);
            const int t = 64 * c + fr; if (t < LP) xcur[ks] = *(const u32x4*)(XBC + (size_t)(b * LP + t) * 512 + 64 * blk + 32 * ks + 8 * kq); }
    }
#pragma unroll 1
    for (int m = 0; m < 4; ++m) {
        if (16 * m >= nvalid) break;
        if (!samp) {
#pragma unroll
            for (int ks = 0; ks < 2; ++ks) { const int t = 64 * c + 16 * (m + 1) + fr; xnext[ks] = (m < 3 && t < LP) ? *(const u32x4*)(XBC + (size_t)(b * LP + t) * 512 + 64 * blk + 32 * ks + 8 * kq) : (u32x4){0u, 0u, 0u, 0u}; }
        }
        const int ra = 16 * m + fr; bf16x8 ua[2];
#pragma unroll
        for (int ks = 0; ks < 2; ++ks) { const int ch0 = 32 * ks + 8 * kq; float uv[8];
            { const f32x4 b0 = *(const f32x4*)(cb + ch0), b1 = *(const f32x4*)(cb + ch0 + 4); uv[0] = b0[0]; uv[1] = b0[1]; uv[2] = b0[2]; uv[3] = b0[3]; uv[4] = b1[0]; uv[5] = b1[1]; uv[6] = b1[2]; uv[7] = b1[3]; }
            if (!samp) {
                const u32x4 cur = xcur[ks], prv = xprev[ks];
#pragma unroll
                for (int sft = 0; sft < 4; ++sft) { const int j = 3 - sft; const f32x4 w0 = *(const f32x4*)(cw + j * 64 + ch0), w1 = *(const f32x4*)(cw + j * 64 + ch0 + 4); u32x4 v = cur;
                    if (sft > 0) {
#pragma unroll
                        for (int d = 0; d < 4; ++d) { const int cr = sft == 1 ? __builtin_amdgcn_update_dpp(0, (int)cur[d], 0x121, 0xf, 0xf, false) : sft == 2 ? __builtin_amdgcn_update_dpp(0, (int)cur[d], 0x122, 0xf, 0xf, false) : __builtin_amdgcn_update_dpp(0, (int)cur[d], 0x123, 0xf, 0xf, false);
                            const int pr = sft == 1 ? __builtin_amdgcn_update_dpp(0, (int)prv[d], 0x121, 0xf, 0xf, false) : sft == 2 ? __builtin_amdgcn_update_dpp(0, (int)prv[d], 0x122, 0xf, 0xf, false) : __builtin_amdgcn_update_dpp(0, (int)prv[d], 0x123, 0xf, 0xf, false);
                            v[d] = (unsigned)(fr >= sft ? cr : pr); } }
                    uv[0] += bflo(v.x) * w0[0]; uv[1] += bfhi(v.x) * w0[1]; uv[2] += bflo(v.y) * w0[2]; uv[3] += bfhi(v.y) * w0[3]; uv[4] += bflo(v.z) * w1[0]; uv[5] += bfhi(v.z) * w1[1]; uv[6] += bflo(v.w) * w1[2]; uv[7] += bfhi(v.w) * w1[3]; }
            } else {
#pragma unroll
                for (int j = 0; j < 4; ++j) { const f32x4 w0 = *(const f32x4*)(cw + j * 64 + ch0), w1 = *(const f32x4*)(cw + j * 64 + ch0 + 4); float xv[8];
                    const int sr = 16 * c + ra, bs = sr >> 2, tau = (sr & 3) + j - 3;
                    if (tau >= 0) { const u32x4 r = *(const u32x4*)(XBC + (size_t)(MP + bs * 4 + tau) * 512 + 64 * blk + ch0);
                        xv[0] = bflo(r.x); xv[1] = bfhi(r.x); xv[2] = bflo(r.y); xv[3] = bfhi(r.y); xv[4] = bflo(r.z); xv[5] = bfhi(r.z); xv[6] = bflo(r.w); xv[7] = bfhi(r.w); }
                    else { const float* sp = A.in[IN_SC] + ((size_t)(l * SB + bs) * 3 + (tau + 3)) * 512 + 64 * blk + ch0; const f32x4 r0 = *(const f32x4*)sp, r1 = *(const f32x4*)(sp + 4);
                        xv[0] = r0[0]; xv[1] = r0[1]; xv[2] = r0[2]; xv[3] = r0[3]; xv[4] = r1[0]; xv[5] = r1[1]; xv[6] = r1[2]; xv[7] = r1[3]; }
                    uv[0] += xv[0] * w0[0]; uv[1] += xv[1] * w0[1]; uv[2] += xv[2] * w0[2]; uv[3] += xv[3] * w0[3]; uv[4] += xv[4] * w1[0]; uv[5] += xv[5] * w1[1]; uv[6] += xv[6] * w1[2]; uv[7] += xv[7] * w1[3]; }
            }
            ua[ks] = __builtin_bit_cast(bf16x8, (u32x4){cvt_pk_bf16(uv[0], uv[1]), cvt_pk_bf16(uv[2], uv[3]), cvt_pk_bf16(uv[4], uv[5]), cvt_pk_bf16(uv[6], uv[7])}); }
#pragma unroll
        for (int nt = 0; nt < 4; ++nt) {
            f32x4 ga = (f32x4){0.f, 0.f, 0.f, 0.f}, gi = ga, gu = ga;
            const int wrow = 16 * nt + fr, wsw = wrow & 7; const unsigned char* wr_ = wl + wrow * 128;
            const bf16x8 wa0 = *(const bf16x8*)(wr_ + ((kq ^ wsw) << 4)), wa1 = *(const bf16x8*)(wr_ + (((4 + kq) ^ wsw) << 4)), wi0 = *(const bf16x8*)(wr_ + 8192 + ((kq ^ wsw) << 4)), wi1 = *(const bf16x8*)(wr_ + 8192 + (((4 + kq) ^ wsw) << 4));
            ga = __builtin_amdgcn_mfma_f32_16x16x32_bf16(ua[0], wa0, ga, 0, 0, 0); ga = __builtin_amdgcn_mfma_f32_16x16x32_bf16(ua[1], wa1, ga, 0, 0, 0);
            gi = __builtin_amdgcn_mfma_f32_16x16x32_bf16(ua[0], wi0, gi, 0, 0, 0); gi = __builtin_amdgcn_mfma_f32_16x16x32_bf16(ua[1], wi1, gi, 0, 0, 0);
            {
                const bool on = kq == ((16 * (nt & 1) + fr) >> 3); const int e = fr & 7; u32x4 idw = (u32x4){0u, 0u, 0u, 0u};
                const unsigned one = (e & 1) ? 0x3f800000u : 0x00003f80u;
                if (on) { if ((e >> 1) == 0) idw.x = one; else if ((e >> 1) == 1) idw.y = one; else if ((e >> 1) == 2) idw.z = one; else idw.w = one; }
                gu = __builtin_amdgcn_mfma_f32_16x16x32_bf16(ua[nt >> 1], __builtin_bit_cast(bf16x8, idw), gu, 0, 0, 0); }
            float av[4], bv[4];
#pragma unroll
            for (int j = 0; j < 4; ++j) { const float r = sigmoidf_(ga[j] + ba[nt]), ig = sigmoidf_(gi[j] + bi[nt]); const float la = r * lsl[nt];
                av[j] = __expf(la); { const float x2 = 2.f * la; const float ser = -x2 * (1.f + x2 * (0.5f + x2 * (0.16666667f + x2 * (0.041666668f + x2 * 0.0083333338f)))); const float alt = __builtin_fmaf(-av[j], av[j], 1.f); const float om = x2 > -0.125f ? ser : alt; bv[j] = __builtin_amdgcn_sqrtf(om) * ig * gu[j]; }
                if (nvalid < 16 * m + 16 && 16 * m + 4 * kq + j >= nvalid) { av[j] = 1.f; bv[j] = 0.f; } }
            float Pj[4], Hj[4];
            if (!samp) {
                Pj[0] = av[0]; Hj[0] = bv[0];
#pragma unroll
                for (int j = 1; j < 4; ++j) { Pj[j] = av[j] * Pj[j - 1]; Hj[j] = av[j] * Hj[j - 1] + bv[j]; }
                float A = Pj[3], B = Hj[3];
                { const float Ap = __shfl_up(A, 16), Bp = __shfl_up(B, 16); if (kq >= 1) { B = A * Bp + B; A = A * Ap; } }
                { const float Ap = __shfl_up(A, 32), Bp = __shfl_up(B, 32); if (kq >= 2) { B = A * Bp + B; A = A * Ap; } }
                float Ae = __shfl_up(A, 16), Be = __shfl_up(B, 16); if (kq == 0) { Ae = 1.f; Be = 0.f; }
                const float A3 = __shfl(A, 48 + fr), B3 = __shfl(B, 48 + fr);
                const float cp = Ae * Pc[nt], chh = Be + Ae * Hc[nt];
#pragma unroll
                for (int j = 0; j < 4; ++j) { Hj[j] = Hj[j] + Pj[j] * chh; Pj[j] = Pj[j] * cp; }
                Hc[nt] = A3 * Hc[nt] + B3; Pc[nt] = A3 * Pc[nt];
            } else {
                const int bs = (16 * c + 16 * m) / 4 + kq; const int ch = 64 * blk + 16 * nt + fr;
                float h = h0v[nt];
#pragma unroll
                for (int j = 0; j < 4; ++j) { h = av[j] * h + bv[j]; Hj[j] = h; Pj[j] = 0.f; }
                out[OFF_SH + (size_t)(l * SB + bs) * 512 + ch] = h;
            }

            { const int rr0 = 16 * m + 4 * kq; const int ch = 64 * blk + 16 * nt + fr; bf16_t* mp = MRG + ((size_t)rowbase + rr0) * DM + 512 + ch; bf16_t* pp = PL + ((size_t)rowbase + rr0) * 512 + ch;
                if (nvalid >= 16 * m + 16) {
#pragma unroll
                    for (int j = 0; j < 4; ++j) { mp[j * DM] = (bf16_t)(cvt_pk_bf16(Hj[j], 0.f) & 0xffffu); pp[j * 512] = (bf16_t)(cvt_pk_bf16(Pj[j], 0.f) & 0xffffu); } }
                else {
#pragma unroll
                    for (int j = 0; j < 4; ++j) if (rr0 + j < nvalid) { mp[j * DM] = (bf16_t)(cvt_pk_bf16(Hj[j], 0.f) & 0xffffu); pp[j * 512] = (bf16_t)(cvt_pk_bf16(Pj[j], 0.f) & 0xffffu); } } }
        }
#pragma unroll
        for (int ks = 0; ks < 2; ++ks) { xprev[ks] = xcur[ks]; xcur[ks] = xnext[ks]; }
    }
    if (!samp && kq == 0) { float* agg = (float*)(ws + WS_AGG) + ((size_t)(b * NCH + c) * 512 + 64 * blk) * 2;
#pragma unroll
        for (int nt = 0; nt < 4; ++nt) *(f32x2*)(agg + (16 * nt + fr) * 2) = (f32x2){Pc[nt], Hc[nt]}; }
}
constexpr int KL_LD = 136, VL_LD = 200, VL_OFF = 192 * KL_LD * 2;
__device__ __forceinline__ void attn_wg_item(const Args& A, Ctx& C, unsigned char* ws, float* out, int l, int it) {
    const int lane = C.lane, n = lane & 15, kq = lane >> 4, h = C.wave, kvh = h >> 2;
    const int b = it / NCH, qt = it - b * NCH, t0 = 64 * qt, kbase = t0 - 128, nsub = (LP - t0 < 64 ? LP - t0 : 64) >> 4;
    const bf16_t* Q = (const bf16_t*)(ws + WS_Q); bf16_t* O = (bf16_t*)(ws + WS_MRG);
    const bf16_t* kP = (const bf16_t*)(ws + WS_KP) + (size_t)b * LP * 128; const bf16_t* vT = (const bf16_t*)(ws + WS_VTP) + (size_t)b * 128 * VTP_LD;
    bf16_t* Kl = (bf16_t*)C.lds; bf16_t* Vl = (bf16_t*)(C.lds + VL_OFF);
    bf16x8 qf[4][2];
#pragma unroll
    for (int sub = 0; sub < 4; ++sub) { const int tq = t0 + 16 * sub + n; const bool ok = tq < LP; const bf16_t* qp = Q + (size_t)(b * LP + (ok ? tq : 0)) * 512 + h * 64 + 8 * kq;
        qf[sub][0] = *(const bf16x8*)qp; qf[sub][1] = *(const bf16x8*)(qp + 32); }
    {
        u32x4 kr[6], vr[6];
#pragma unroll
        for (int i = 0; i < 6; ++i) { const int idx = i * 512 + C.tid; const int row = idx >> 4, ch8 = (idx & 15) * 8, t = kbase + row;
            kr[i] = (t >= 0 && t < LP) ? *(const u32x4*)(kP + (size_t)t * 128 + ch8) : (u32x4){0u, 0u, 0u, 0u};
            const int drow = idx / 24, ck = idx - drow * 24, tv = kbase + 8 * ck;
            vr[i] = tv >= 0 ? *(const u32x4*)(vT + (size_t)drow * VTP_LD + tv) : (u32x4){0u, 0u, 0u, 0u}; }
#pragma unroll
        for (int i = 0; i < 6; ++i) { const int idx = i * 512 + C.tid; const int row = idx >> 4, ch8 = (idx & 15) * 8; *(u32x4*)(Kl + row * KL_LD + ch8) = kr[i];
            const int drow = idx / 24, ck = idx - drow * 24; *(u32x4*)(Vl + drow * VL_LD + 8 * ck) = vr[i]; }
    }
    __syncthreads();
    const float sink = A.in[IN_SINK][l * 8 + h];
    for (int sub = 0; sub < nsub; ++sub) {
        const int tq = t0 + 16 * sub + n; const size_t qrow = (size_t)b * LP + tq;
        const bf16x8 q0 = sub == 0 ? qf[0][0] : sub == 1 ? qf[1][0] : sub == 2 ? qf[2][0] : qf[3][0], q1 = sub == 0 ? qf[0][1] : sub == 1 ? qf[1][1] : sub == 2 ? qf[2][1] : qf[3][1];
        f32x4 s[9]; float mx = sink;
#pragma unroll
        for (int T = 0; T < 9; ++T) { const bf16_t* kp = Kl + (16 * (sub + T) + n) * KL_LD + kvh * 64 + 8 * kq; const bf16x8 k0 = *(const bf16x8*)kp, k1 = *(const bf16x8*)(kp + 32);
            s[T] = (f32x4){0.f, 0.f, 0.f, 0.f};
            s[T] = __builtin_amdgcn_mfma_f32_16x16x32_bf16(k0, q0, s[T], 0, 0, 0); s[T] = __builtin_amdgcn_mfma_f32_16x16x32_bf16(k1, q1, s[T], 0, 0, 0);
#pragma unroll
            for (int j = 0; j < 4; ++j) { const int key = kbase + 16 * (sub + T) + 4 * kq + j; const bool ok = (key >= 0) && (key <= tq) && (key > tq - 128); s[T][j] = ok ? s[T][j] : -INFINITY; mx = fmaxf(mx, s[T][j]); } }
        mx = fmaxf(mx, __shfl_xor(mx, 16)); mx = fmaxf(mx, __shfl_xor(mx, 32));
        float sum = 0.f; u32x2 pk[9];
#pragma unroll
        for (int T = 0; T < 9; ++T) { float p[4];
#pragma unroll
            for (int j = 0; j < 4; ++j) { p[j] = __expf(s[T][j] - mx); sum += p[j]; }
            pk[T] = (u32x2){cvt_pk_bf16(p[0], p[1]), cvt_pk_bf16(p[2], p[3])}; }
        sum += __shfl_xor(sum, 16); sum += __shfl_xor(sum, 32);
        sum += __expf(sink - mx);
        const float rl = __builtin_amdgcn_rcpf(sum);
        f32x4 o[4];
#pragma unroll
        for (int dt = 0; dt < 4; ++dt) o[dt] = (f32x4){0.f, 0.f, 0.f, 0.f};
#pragma unroll
        for (int pr = 0; pr < 5; ++pr) { const int Ta = 2 * pr - 1, Tb = 2 * pr;
            const u32x2 pa = Ta >= 0 ? pk[Ta < 0 ? 0 : Ta] : (u32x2){0u, 0u}, pb = pk[Tb];
            const bf16x8 pf = __builtin_bit_cast(bf16x8, (u32x4){pa.x, pa.y, pb.x, pb.y});
#pragma unroll
            for (int dt = 0; dt < 4; ++dt) { const bf16_t* vp = Vl + (kvh * 64 + 16 * dt + n) * VL_LD + 4 * kq;
                const u32x2 va = *(const u32x2*)(vp + 16 * (sub + (Ta < 0 ? 0 : Ta))), vb = *(const u32x2*)(vp + 16 * (sub + Tb));
                const bf16x8 vf = __builtin_bit_cast(bf16x8, (u32x4){va.x, va.y, vb.x, vb.y});
                o[dt] = __builtin_amdgcn_mfma_f32_16x16x32_bf16(vf, pf, o[dt], 0, 0, 0); } }
#pragma unroll
        for (int dt = 0; dt < 4; ++dt) *(u32x2*)(O + qrow * DM + h * 64 + 16 * dt + 4 * kq) = (u32x2){cvt_pk_bf16(o[dt][0] * rl, o[dt][1] * rl), cvt_pk_bf16(o[dt][2] * rl, o[dt][3] * rl)};
    }
    __syncthreads();
}
__device__ __forceinline__ void p2_mixer(const Args& A, Ctx& C, int l) {
    OPQ_PTRS; asm volatile("" : "+s"(l)); asm volatile("" : "+v"(C.lane), "+v"(C.tid));
    constexpr int N_LRU = NB * NCH * 8 + 32 * 8, N_ATTP = NB * 129 * 8, N_SAMP = SB * 2;
    for (int it = C.vcu; it < NB * NCH; it += 256) attn_wg_item(A, C, ws, out, l, it);
    unsigned char* wl = C.lds + C.wave * 16384; float* cwl = (float*)(C.lds + 131072 + 64 + C.wave * 2304);
    { const int blk = C.wave; const bf16_t* lwA = (const bf16_t*)(ws + WS_LRUW) + (size_t)(l * 8 + blk) * 4096; const bf16_t* lwI = lwA + DEPTH * 8 * 4096;
        u32x4 ta[8], ti[8];
#pragma unroll
        for (int i = 0; i < 8; ++i) { ta[i] = *((const u32x4*)lwA + i * 64 + C.lane); ti[i] = *((const u32x4*)lwI + i * 64 + C.lane); }
        float cv[5];
#pragma unroll
        for (int j = 0; j < 4; ++j) cv[j] = A.in[IN_CONVW][(size_t)l * 4 * 512 + j * 512 + 64 * blk + C.lane];
        cv[4] = A.in[IN_CONVB][l * 512 + 64 * blk + C.lane];
    const float sba = A.in[IN_BA][l * 512 + 64 * blk + C.lane], sbi = A.in[IN_BI][l * 512 + 64 * blk + C.lane], slm = A.in[IN_LAM][l * 512 + 64 * blk + C.lane];
#pragma unroll
        for (int i = 0; i < 8; ++i) { const int idx = i * 64 + C.lane, row = idx >> 3, ch = idx & 7; *(u32x4*)(wl + row * 128 + ((ch ^ (row & 7)) << 4)) = ta[i]; *(u32x4*)(wl + 8192 + row * 128 + ((ch ^ (row & 7)) << 4)) = ti[i]; }
#pragma unroll
        for (int j = 0; j < 5; ++j) cwl[j * 64 + C.lane] = cv[j];
    cwl[320 + C.lane] = sba; cwl[384 + C.lane] = sbi; cwl[448 + C.lane] = 8.0f * (fminf(slm, 0.f) - log1pf(__expf(-fabsf(slm))));
        asm volatile("s_waitcnt lgkmcnt(0)" ::: "memory"); }
    for (int it = (255 - C.vcu) * NWAVES + C.wave; it < N_LRU + N_SAMP; it += 256 * NWAVES) { if (it < N_LRU) lru_item(A, C, ws, out, l, it, wl, cwl); else attn_item(A, C, ws, out, l, N_ATTP + it - N_LRU); }
    __syncthreads();
}
__device__ __forceinline__ void p3_fixup(const Args& A, Ctx& C, int l) {
    OPQ_PTRS; asm volatile("" : "+s"(l)); asm volatile("" : "+v"(C.lane), "+v"(C.tid));
    float* hin = (float*)C.lds; bf16_t* MRG = (bf16_t*)(ws + WS_MRG); const bf16_t* PL = (const bf16_t*)(ws + WS_PL); const bf16_t* G = (const bf16_t*)(ws + WS_G);
    const float* agg = (const float*)(ws + WS_AGG);
    for (int it = C.vcu; it < NB * NCH + 8 + 2; it += 256) {
        __syncthreads();
        if (it >= NB * NCH + 8) {
            const int r0 = MV + 64 * (it - NB * NCH - 8);
            for (int e = C.tid; e < 64 * 128; e += NTHREADS) *((u32x4*)(MRG + (size_t)r0 * DM) + e) = (u32x4){0u, 0u, 0u, 0u};
            continue; }
        const bool samp = it >= NB * NCH;
        int b, c; if (it < 256) { b = it >> 5; c = it & 31; } else { b = it - 256; c = NCH - 1; }
        const int rowbase = samp ? MP + 64 * (it - NB * NCH) : b * LP + 64 * c; const int nvalid = samp ? 64 : (LP - 64 * c < 64 ? LP - 64 * c : 64);
        float h = 0.f;
        if (!samp) { const f32x2* ap = (const f32x2*)agg + (size_t)b * NCH * 512 + C.tid;
            for (int c0 = 0; c0 < c; c0 += 8) { f32x2 ab[8];
#pragma unroll
                for (int k = 0; k < 8; ++k) ab[k] = (c0 + k < c) ? ap[(size_t)(c0 + k) * 512] : (f32x2){1.f, 0.f};
#pragma unroll
                for (int k = 0; k < 8; ++k) h = ab[k][0] * h + ab[k][1]; }
            if (c == NCH - 1) { const f32x2 ab = ap[(size_t)c * 512]; out[OFF_PH + (size_t)(l * NB + b) * 512 + C.tid] = ab[0] * h + ab[1]; } }
        hin[C.tid] = h;
        __syncthreads();
        float hv[8];
#pragma unroll
        for (int e = 0; e < 8; ++e) hv[e] = hin[8 * C.lane + e];
        for (int r0 = C.wave; r0 < nvalid; r0 += 4 * NWAVES) {
            u32x4 a[4], hl[4], pl[4], g[4]; bool ok[4];
#pragma unroll
            for (int q = 0; q < 4; ++q) { const int r = r0 + 8 * q; ok[q] = r < nvalid; const size_t row = (size_t)rowbase + (ok[q] ? r : r0);
                a[q] = *((const u32x4*)(MRG + row * DM) + C.lane); hl[q] = *((const u32x4*)(MRG + row * DM + 512) + C.lane); pl[q] = *((const u32x4*)(PL + row * 512) + C.lane); g[q] = *((const u32x4*)(G + row * 512) + C.lane); }
            float av[4][8], ov[4][8], sa[4], so[4];
#pragma unroll
            for (int q = 0; q < 4; ++q) {
                const float a8[8] = {bflo(a[q].x), bfhi(a[q].x), bflo(a[q].y), bfhi(a[q].y), bflo(a[q].z), bfhi(a[q].z), bflo(a[q].w), bfhi(a[q].w)};
                const float hlv[8] = {bflo(hl[q].x), bfhi(hl[q].x), bflo(hl[q].y), bfhi(hl[q].y), bflo(hl[q].z), bfhi(hl[q].z), bflo(hl[q].w), bfhi(hl[q].w)};
                const float plv[8] = {bflo(pl[q].x), bfhi(pl[q].x), bflo(pl[q].y), bfhi(pl[q].y), bflo(pl[q].z), bfhi(pl[q].z), bflo(pl[q].w), bfhi(pl[q].w)};
                const float gv[8] = {bflo(g[q].x), bfhi(g[q].x), bflo(g[q].y), bfhi(g[q].y), bflo(g[q].z), bfhi(g[q].z), bflo(g[q].w), bfhi(g[q].w)};
                sa[q] = 0.f; so[q] = 0.f;
#pragma unroll
                for (int e = 0; e < 8; ++e) { av[q][e] = a8[e]; ov[q][e] = (hlv[e] + plv[e] * hv[e]) * gv[e]; sa[q] += a8[e] * a8[e]; so[q] += ov[q][e] * ov[q][e]; } }
#pragma unroll
            for (int o = 1; o < 64; o <<= 1) {
#pragma unroll
                for (int q = 0; q < 4; ++q) { sa[q] += __shfl_xor(sa[q], o); so[q] += __shfl_xor(so[q], o); } }
#pragma unroll
            for (int q = 0; q < 4; ++q) { if (!ok[q]) continue; const size_t row = (size_t)rowbase + r0 + 8 * q;
                const float ra = rsqrtf(sa[q] * (1.f / 512.f) + EPS), ro = rsqrtf(so[q] * (1.f / 512.f) + EPS);
                *((u32x4*)(MRG + row * DM) + C.lane) = (u32x4){cvt_pk_bf16(av[q][0] * ra, av[q][1] * ra), cvt_pk_bf16(av[q][2] * ra, av[q][3] * ra), cvt_pk_bf16(av[q][4] * ra, av[q][5] * ra), cvt_pk_bf16(av[q][6] * ra, av[q][7] * ra)};
                *((u32x4*)(MRG + row * DM + 512) + C.lane) = (u32x4){cvt_pk_bf16(ov[q][0] * ro, ov[q][1] * ro), cvt_pk_bf16(ov[q][2] * ro, ov[q][3] * ro), cvt_pk_bf16(ov[q][4] * ro, ov[q][5] * ro), cvt_pk_bf16(ov[q][6] * ro, ov[q][7] * ro)}; }
        }
    }
}
__device__ __forceinline__ void fixup_slab(const Args& A, Ctx& C, int l, int r0, unsigned* slabcnt, const unsigned* xcc_of, int pm) {
    OPQ_PTRS; asm volatile("" : "+s"(l), "+s"(r0)); asm volatile("" : "+v"(C.lane), "+v"(C.tid));
    float* hin = (float*)C.lds;
    bf16_t* MRG = (bf16_t*)(ws + WS_MRG); const bf16_t* PL = (const bf16_t*)(ws + WS_PL); const float* agg = (const float*)(ws + WS_AGG);
    const bf16_t* G = (const bf16_t*)(ws + WS_G) + (r0 >= (int)TAIL_ROW0 ? G_DELTA : 0);
    int pos1 = 64, pos2 = 64;
    if (r0 >= MV) { for (int e = C.tid; e < 64 * 128; e += NTHREADS) *((u32x4*)(MRG + (size_t)r0 * DM) + e) = (u32x4){0u, 0u, 0u, 0u}; }
    else {
        if (r0 >= MP) { hin[C.tid] = 0.f; }
        else {
            const int b0 = r0 / LP, t0 = r0 - b0 * LP, c0 = t0 >> 6;
            const int end0 = (64 * (c0 + 1) < LP ? 64 * (c0 + 1) : LP) - t0;
            float h = 0.f;
            { const f32x2* ap = (const f32x2*)agg + (size_t)b0 * NCH * 512 + C.tid; f32x2 ab[32];
#pragma unroll
                for (int k = 0; k < 32; ++k) ab[k] = (k < c0) ? ap[(size_t)k * 512] : (f32x2){1.f, 0.f};
#pragma unroll
                for (int k = 0; k < 32; ++k) h = ab[k][0] * h + ab[k][1];
                hin[C.tid] = h;
                int b = b0, c = c0, pos = end0 < 64 ? end0 : 64;
                if (c == NCH - 1) { const f32x2 abl = ap[(size_t)c * 512]; out[OFF_PH + (size_t)(l * NB + b) * 512 + C.tid] = abl[0] * h + abl[1]; }
                if (pos < 64) {
                    pos1 = pos;
                    if (t0 + pos == LP) { b = b0 + 1; c = 0; h = 0.f; } else { const f32x2 x = ap[(size_t)c * 512]; h = x[0] * h + x[1]; c = c + 1; }
                    hin[512 + C.tid] = h;
                    const int tcur = (b == b0) ? t0 + pos : 0; const int cend = (64 * (c + 1) < LP ? 64 * (c + 1) : LP) - tcur; const int len1 = cend < 64 - pos ? cend : 64 - pos;
                    if (b == b0 && c == NCH - 1) { const f32x2 abl = ap[(size_t)c * 512]; out[OFF_PH + (size_t)(l * NB + b) * 512 + C.tid] = abl[0] * h + abl[1]; }
                    pos += len1;
                    if (pos < 64) {
                        pos2 = pos; hin[1024 + C.tid] = 0.f; } } }
        }
        __syncthreads();
        for (int rr = C.wave; rr < 64; rr += 4 * NWAVES) {
            u32x4 a[4], hl[4], pl[4], g[4]; int sg[4];
#pragma unroll
            for (int q = 0; q < 4; ++q) { const int r = rr + 8 * q; const size_t row = (size_t)r0 + r; sg[q] = (r >= pos1 ? 1 : 0) + (r >= pos2 ? 1 : 0);
                a[q] = *((const u32x4*)(MRG + row * DM) + C.lane); hl[q] = *((const u32x4*)(MRG + row * DM + 512) + C.lane); pl[q] = *((const u32x4*)(PL + row * 512) + C.lane); g[q] = *((const u32x4*)(G + row * 512) + C.lane); }
            float av[4][8], ov[4][8], sa[4], so[4];
#pragma unroll
            for (int q = 0; q < 4; ++q) {
                const float* hq = hin + 512 * sg[q] + 8 * C.lane; const f32x4 h0 = *(const f32x4*)hq, h1 = *(const f32x4*)(hq + 4); const float hv[8] = {h0[0], h0[1], h0[2], h0[3], h1[0], h1[1], h1[2], h1[3]};
                const float a8[8] = {bflo(a[q].x), bfhi(a[q].x), bflo(a[q].y), bfhi(a[q].y), bflo(a[q].z), bfhi(a[q].z), bflo(a[q].w), bfhi(a[q].w)};
                const float hlv[8] = {bflo(hl[q].x), bfhi(hl[q].x), bflo(hl[q].y), bfhi(hl[q].y), bflo(hl[q].z), bfhi(hl[q].z), bflo(hl[q].w), bfhi(hl[q].w)};
                const float plv[8] = {bflo(pl[q].x), bfhi(pl[q].x), bflo(pl[q].y), bfhi(pl[q].y), bflo(pl[q].z), bfhi(pl[q].z), bflo(pl[q].w), bfhi(pl[q].w)};
                const float gv[8] = {bflo(g[q].x), bfhi(g[q].x), bflo(g[q].y), bfhi(g[q].y), bflo(g[q].z), bfhi(g[q].z), bflo(g[q].w), bfhi(g[q].w)};
                sa[q] = 0.f; so[q] = 0.f;
#pragma unroll
                for (int e = 0; e < 8; ++e) { av[q][e] = a8[e]; ov[q][e] = (hlv[e] + plv[e] * hv[e]) * gv[e]; sa[q] += a8[e] * a8[e]; so[q] += ov[q][e] * ov[q][e]; } }
#pragma unroll
            for (int o = 1; o < 64; o <<= 1) {
#pragma unroll
                for (int q = 0; q < 4; ++q) { sa[q] += __shfl_xor(sa[q], o); so[q] += __shfl_xor(so[q], o); } }
#pragma unroll
            for (int q = 0; q < 4; ++q) { const size_t row = (size_t)r0 + rr + 8 * q;
                const float ra = rsqrtf(sa[q] * (1.f / 512.f) + EPS), ro = rsqrtf(so[q] * (1.f / 512.f) + EPS);
                *((u32x4*)(MRG + row * DM) + C.lane) = (u32x4){cvt_pk_bf16(av[q][0] * ra, av[q][1] * ra), cvt_pk_bf16(av[q][2] * ra, av[q][3] * ra), cvt_pk_bf16(av[q][4] * ra, av[q][5] * ra), cvt_pk_bf16(av[q][6] * ra, av[q][7] * ra)};
                *((u32x4*)(MRG + row * DM + 512) + C.lane) = (u32x4){cvt_pk_bf16(ov[q][0] * ro, ov[q][1] * ro), cvt_pk_bf16(ov[q][2] * ro, ov[q][3] * ro), cvt_pk_bf16(ov[q][4] * ro, ov[q][5] * ro), cvt_pk_bf16(ov[q][6] * ro, ov[q][7] * ro)}; }
        }
    }
    asm volatile("s_waitcnt vmcnt(0)" ::: "memory"); __syncthreads();
    if (C.wave == 0) {
        const unsigned my = ((unsigned)__builtin_amdgcn_s_getreg((3 << 11) | 20) & 0xFu) + 1u;
        const unsigned v = (pm < 64 && C.lane < 4) ? __hip_atomic_load(xcc_of + 4 * pm + C.lane, __ATOMIC_RELAXED, __HIP_MEMORY_SCOPE_AGENT) : (pm < 64 ? my : 0u);
        if (__builtin_amdgcn_ballot_w64(v != my) != 0ull) __builtin_amdgcn_fence(__ATOMIC_RELEASE, "agent");
        asm volatile("s_waitcnt vmcnt(0)" ::: "memory");
        if (C.lane == 0) __hip_atomic_fetch_add(slabcnt + 64 * pm, 1u, __ATOMIC_RELAXED, __HIP_MEMORY_SCOPE_AGENT);
        unsigned spins = 0;
        while ((unsigned)__builtin_amdgcn_readfirstlane(__hip_atomic_load(slabcnt + 64 * pm, __ATOMIC_RELAXED, __HIP_MEMORY_SCOPE_AGENT)) < 4u) { if (++spins > (1u << 22)) break; __builtin_amdgcn_s_sleep(2); }
        __builtin_amdgcn_fence(__ATOMIC_ACQUIRE, "agent"); asm volatile("s_waitcnt vmcnt(0)" ::: "memory"); }
    __syncthreads();
}
__global__ void __launch_bounds__(NTHREADS) hymba_fwd(Args args) {
    const Args& A = args;
    extern __shared__ __attribute__((aligned(16))) unsigned char lds[];
    cg::grid_group grid = cg::this_grid();
    Ctx C;
    C.lds = lds;
    C.tid = threadIdx.x; C.lane = C.tid & 63; C.wave = __builtin_amdgcn_readfirstlane(C.tid >> 6);
    { const int bx = blockIdx.x; C.vcu = (bx % 8) * 32 + bx / 8; }
    C.gw = C.vcu * NWAVES + C.wave;
    PG8_LAS unsigned char* ring = (PG8_LAS unsigned char*)lds;
    volatile __attribute__((address_space(3))) unsigned* xb_st = (volatile __attribute__((address_space(3))) unsigned*)((PG8_LAS unsigned char*)lds + 131072);
    if (threadIdx.x < 2) xb_st[threadIdx.x] = 0u;
    __syncthreads();
    { u32x4* cz = (u32x4*)(args.ws + WS_CTL); for (int i = blockIdx.x * NTHREADS + threadIdx.x; i < (int)(CTL_BYTES / 16); i += 256 * NTHREADS) cz[i] = (u32x4){0u, 0u, 0u, 0u}; }
#ifndef NO_P0
    p0_prologue(A, C);
#endif
    grid.sync();
    XcdBarrier xbar = xcd_barrier_post((unsigned*)(args.ws + WS_CTL) + CW_XBAR, xb_st);
    if (threadIdx.x == 0) __hip_atomic_store((unsigned*)(args.ws + WS_CTL) + CW_XCC + C.vcu, xbar.x + 1u, __ATOMIC_RELAXED, __HIP_MEMORY_SCOPE_AGENT);
    for (int l = 0; l < DEPTH; ++l) {
#ifndef NO_P1
        {
            OPQ_PTRS; int ll = l; asm volatile("" : "+s"(ll)); const unsigned char* wb = ws + WS_W + (size_t)ll * W_LAYER_B; unsigned* ctl = (unsigned*)(ws + WS_CTL); float* xmeta = (float*)(ws + WS_XMETA); float* xss = (float*)(ws + WS_XSS); bf16_t* xb16 = (bf16_t*)(ws + WS_XB16); (void)ctl; (void)xmeta; (void)wb;
            pg8::Gemm g{xb16, (const bf16_t*)wb, MPAD, IN_W, DM}; pg8::GatedOrder S{C.vcu, 7, 1, ctl + CW_READY + (ll > 0 ? 2 * ll - 1 : 0) * SEAM_BANK, ctl + CW_GD16 + (ll > 0 ? 2 * ll - 1 : 0) * 1024, ll > 0 ? 32u : 0u, 0};
            pg8::EpiIn E{xss, (bf16_t*)(ws + WS_Q), (bf16_t*)(ws + WS_KP), (bf16_t*)(ws + WS_VTP), (bf16_t*)(ws + WS_KS), (bf16_t*)(ws + WS_VTS), (bf16_t*)(ws + WS_XBC), (bf16_t*)(ws + WS_G), out, ll};
            pg8::gemm_phase<pg8::EpiIn, pg8::GatedOrder, true, true>(ring, g, S, E);
        }
#endif
        xcd_barrier(xbar);
#ifndef NO_P2
        p2_mixer(A, C, l);
#endif
        xcd_barrier(xbar);
#ifndef NO_P4
        for (int round = 0; round < 2; ++round) {
            OPQ_PTRS; int ll = l; asm volatile("" : "+s"(ll)); const unsigned char* wb = ws + WS_W + (size_t)ll * W_LAYER_B; unsigned* ctl = (unsigned*)(ws + WS_CTL); float* xmeta = (float*)(ws + WS_XMETA); float* xss = (float*)(ws + WS_XSS); bf16_t* xb16 = (bf16_t*)(ws + WS_XB16); (void)ctl; (void)xmeta; (void)wb;
            pg8::Gemm g{(const bf16_t*)(ws + WS_MRG), (const bf16_t*)(wb + W_IN_B), MPAD, DM, DM}; pg8::PanelOrder S{C.vcu, round, nullptr};
            pg8::EpiRes E{out, 0, xb16, xss, A.in[IN_POSTMIX] + ll * DM, (unsigned*)(ws + WS_XBUF), ctl + CW_SEAM + (2 * ll) * SEAM_BANK, ctl + CW_READY + (2 * ll) * SEAM_BANK, ctl + CW_GD16 + (2 * ll) * 1024, ctl + CW_XCC};
            { pg8::Unit su; if (S.next(0, su)) fixup_slab(A, C, l, 256 * su.pm + 64 * su.pn, ctl + CW_SLAB + ll * SEAM_BANK, ctl + CW_XCC, su.pm); }
            pg8::gemm_phase<pg8::EpiRes, pg8::PanelOrder, false, true>(ring, g, S, E);
            __syncthreads();
        }
#endif
#ifndef NO_P6
        {
            OPQ_PTRS; int ll = l; asm volatile("" : "+s"(ll)); const unsigned char* wb = ws + WS_W + (size_t)ll * W_LAYER_B; unsigned* ctl = (unsigned*)(ws + WS_CTL); float* xmeta = (float*)(ws + WS_XMETA); float* xss = (float*)(ws + WS_XSS); bf16_t* xb16 = (bf16_t*)(ws + WS_XB16); (void)ctl; (void)xmeta; (void)wb;
            pg8::Gemm g{xb16, (const bf16_t*)(wb + W_IN_B + W_OUT_B), MPAD, 2 * D_FF, DM}; pg8::GatedOrder S{C.vcu, 22, 2, ctl + CW_READY + (2 * ll) * SEAM_BANK, ctl + CW_GD16 + (2 * ll) * 1024, 32u, 0};
            pg8::EpiGU E{xss, (bf16_t*)(ws + WS_HACT)};
            pg8::gemm_phase<pg8::EpiGU, pg8::GatedOrder, true, true>(ring, g, S, E);
            __syncthreads();
            if (C.wave == 0) { const unsigned my = ((unsigned)__builtin_amdgcn_s_getreg((3 << 11) | 20) & 0xFu) + 1u;
                const unsigned v = C.lane < 32 ? __hip_atomic_load(ctl + CW_XCC + (C.vcu & ~31) + C.lane, __ATOMIC_RELAXED, __HIP_MEMORY_SCOPE_AGENT) : my;
                if (__builtin_amdgcn_ballot_w64(v != my) != 0ull) __builtin_amdgcn_fence(__ATOMIC_RELEASE, "agent");
                asm volatile("s_waitcnt vmcnt(0)" ::: "memory");
                if (C.lane == 0) __hip_atomic_fetch_add(ctl + CW_GRP + ll * 512 + 64 * (C.vcu >> 5), 1u, __ATOMIC_RELAXED, __HIP_MEMORY_SCOPE_AGENT); }
        }
#endif
#ifndef NO_P7
        for (int round = 0; round < 2; ++round) {
            OPQ_PTRS; int ll = l; asm volatile("" : "+s"(ll)); const unsigned char* wb = ws + WS_W + (size_t)ll * W_LAYER_B; unsigned* ctl = (unsigned*)(ws + WS_CTL); float* xmeta = (float*)(ws + WS_XMETA); float* xss = (float*)(ws + WS_XSS); bf16_t* xb16 = (bf16_t*)(ws + WS_XB16); (void)ctl; (void)xmeta; (void)wb;
            pg8::Gemm g{(const bf16_t*)(ws + WS_HACT), (const bf16_t*)(wb + W_IN_B + W_OUT_B + W_GU_B), MPAD, DM, D_FF}; pg8::PanelOrder S{C.vcu, round, ctl + CW_GRP + ll * 512};
            pg8::EpiRes E{out, ll == DEPTH - 1 ? 1 : 0, xb16, xss, A.in[IN_POSTFFN] + ll * DM, (unsigned*)(ws + WS_XBUF), ctl + CW_SEAM + (2 * ll + 1) * SEAM_BANK, ctl + CW_READY + (2 * ll + 1) * SEAM_BANK, ctl + CW_GD16 + (2 * ll + 1) * 1024, ctl + CW_XCC};
            pg8::gemm_phase<pg8::EpiRes, pg8::PanelOrder, false, true>(ring, g, S, E);
            __syncthreads();
        }
#endif
    }
}

extern "C" void kernel_launch(void* const* d_in, const int* in_sizes, int n_in, void* d_out, int out_size, void* d_ws, size_t ws_size, hipStream_t stream) {
    static int grid = 0;
    if (grid == 0) {
        if (n_in != 26 || ws_size < WS_END) { fprintf(stderr, "kernel_launch: unexpected inputs (n_in %d, ws %zu)\n", n_in, ws_size); grid = -1; return; }
        int dev = 0, cus = 0, per_cu = 0;
        (void)hipGetDevice(&dev); (void)hipDeviceGetAttribute(&cus, hipDeviceAttributeMultiprocessorCount, dev);
        if (hipFuncSetAttribute((const void*)hymba_fwd, hipFuncAttributeMaxDynamicSharedMemorySize, LDS_BYTES) != hipSuccess) { fprintf(stderr, "kernel_launch: hipFuncSetAttribute failed\n"); grid = -1; return; }
        if (hipOccupancyMaxActiveBlocksPerMultiprocessor(&per_cu, (const void*)hymba_fwd, NTHREADS, LDS_BYTES) != hipSuccess || per_cu < 1) { fprintf(stderr, "kernel_launch: occupancy query says %d\n", per_cu); grid = -1; return; }
        if (cus < 256) { fprintf(stderr, "kernel_launch: needs 256 CUs, device has %d\n", cus); grid = -1; return; }
        grid = 256;
    }
    if (grid < 0) return;
    Args a{};
    for (int i = 0; i < 26; ++i) a.in[i] = (const float*)d_in[i];
    a.out = (float*)d_out; a.ws = (unsigned char*)d_ws;
    void* kargs[] = {&a};
    hipError_t e = hipLaunchCooperativeKernel((const void*)hymba_fwd, dim3(grid), dim3(NTHREADS), kargs, LDS_BYTES, stream);
    if (e != hipSuccess) fprintf(stderr, "cooperative launch failed: %s\n", hipGetErrorString(e));
}
```

```cpp
#include <hip/hip_runtime.h>
#include <hip/hip_cooperative_groups.h>
#include <cstdio>
#include <cstdint>
namespace cg = cooperative_groups;

constexpr int DM = 1024, NB = 8, SEQ = 2048, LP = 2064, DEPTH = 4, SB = 128, SS = 4, NMETA = 16;
constexpr int ATT_W = 512, LRU_W = 512, D_FF = 2816, IN_W = 1792;
constexpr int MP = NB * LP;
constexpr int MS = SB * SS;
constexpr int MV = MP + MS;
constexpr int MPAD = 17152;
constexpr int NCH = 33;
constexpr int VTP_LD = 2080, VTS_LD = 144, KS_ROWS = 144;
constexpr float EPS = 1e-6f;
constexpr size_t OFF_YP = 0, OFF_YS = OFF_YP + (size_t)NB * SEQ * DM, OFF_PK = OFF_YS + (size_t)MS * DM, OFF_PV = OFF_PK + (size_t)DEPTH * NB * 128 * 128,
                 OFF_PH = OFF_PV + (size_t)DEPTH * NB * 128 * 128, OFF_PC = OFF_PH + (size_t)DEPTH * NB * 512, OFF_SK = OFF_PC + (size_t)DEPTH * NB * 3 * 512,
                 OFF_SV = OFF_SK + (size_t)DEPTH * SB * 128 * 128, OFF_SH = OFF_SV + (size_t)DEPTH * SB * 128 * 128, OFF_SC = OFF_SH + (size_t)DEPTH * SB * 512;
constexpr size_t MiB = 1u << 20;
constexpr size_t WS_CTL = 0, CTL_BYTES = 1 * MiB, WS_XMETA = 1 * MiB, WS_XSS = 2 * MiB, WS_XBUF = 4 * MiB, WS_AGG = 5 * MiB, WS_LRUW = 7 * MiB, WS_W = 8 * MiB;
constexpr size_t W_IN_B = (size_t)IN_W * DM * 2, W_OUT_B = (size_t)DM * DM * 2, W_GU_B = (size_t)2 * D_FF * DM * 2, W_D_B = (size_t)DM * D_FF * 2, W_LAYER_B = W_IN_B + W_OUT_B + W_GU_B + W_D_B;
constexpr size_t WS_XB16 = 96 * MiB, WS_KP = 130 * MiB, WS_VTP = 135 * MiB, WS_KS = 140 * MiB, WS_VTS = 158 * MiB;
constexpr size_t WS_Q = 176 * MiB, WS_XBC = 193 * MiB, WS_G = 210 * MiB, WS_PL = 252 * MiB + 256 * 1024, WS_MRG = 269 * MiB + 256 * 1024, WS_HACT = 176 * MiB, WS_GT = 303 * MiB, WS_END = 304 * MiB;
constexpr long TAIL_ROW0 = 16384, G_DELTA = (long)((WS_GT - WS_G) / 2) - TAIL_ROW0 * 512;
static_assert(WS_PL + (size_t)TAIL_ROW0 * 1024 >= WS_HACT + (size_t)MPAD * D_FF * 2 && WS_PL + (size_t)MPAD * 1024 <= WS_MRG && WS_MRG + (size_t)MPAD * 2048 <= WS_GT, "tail rows outside the hact overlay");
static_assert(WS_W + 4 * W_LAYER_B <= WS_XB16 && WS_HACT + (size_t)MPAD * D_FF * 2 <= WS_END, "ws map");
constexpr int CW_SEAM = 4096, SEAM_BANK = 128 * 64, CW_READY = 131072, CW_GDONE = 196608, CW_XBAR = 200704, CW_XCC = 208896, CW_GD16 = 212992, CW_SLAB = 221184, CW_GRP = 253952;

typedef unsigned short bf16_t;
typedef short bf16x8 __attribute__((ext_vector_type(8)));
typedef short bf16x4 __attribute__((ext_vector_type(4)));
typedef float f32x4 __attribute__((ext_vector_type(4)));
typedef float f32x2 __attribute__((ext_vector_type(2)));
typedef unsigned u32x4 __attribute__((ext_vector_type(4)));
typedef unsigned u32x2 __attribute__((ext_vector_type(2)));

__device__ __forceinline__ unsigned cvt_pk_bf16(float lo, float hi) { unsigned r; asm volatile("v_cvt_pk_bf16_f32 %0, %1, %2" : "=v"(r) : "v"(lo), "v"(hi)); return r; }
__device__ __forceinline__ float bf2f(unsigned short b) { return __uint_as_float((unsigned)b << 16); }
__device__ __forceinline__ float bflo(unsigned w) { return __uint_as_float(w << 16); }
__device__ __forceinline__ float bfhi(unsigned w) { return __uint_as_float(w & 0xffff0000u); }
__device__ __forceinline__ float gelu_tanh(float x) { const float y = 0.7978845608f * (x + 0.044715f * x * x * x); return x * __builtin_amdgcn_rcpf(1.f + __expf(-2.f * y)); }
__device__ __forceinline__ float sigmoidf_(float x) { return __builtin_amdgcn_rcpf(1.f + __expf(-x)); }
__device__ __forceinline__ float wave_sum(float v) {
#pragma unroll
    for (int o = 1; o < 64; o <<= 1) v += __shfl_xor(v, o);
    return v;
}
__device__ __forceinline__ float* xrow_ptr(float* out, float* xmeta, int row) {
    if (row < MP) { const int b = row / LP, t = row - b * LP; return t >= NMETA ? out + OFF_YP + ((size_t)b * SEQ + (t - NMETA)) * DM : xmeta + (size_t)(b * NMETA + t) * DM; }
    if (row < MV) return out + OFF_YS + (size_t)(row - MP) * DM;
    return xmeta + (size_t)(128 + row - MV) * DM;
}
namespace pg8 {
#define PG8_LAS __attribute__((address_space(3)))
typedef unsigned short bf16_t;
typedef short bf16x8 __attribute__((ext_vector_type(8)));
typedef float f32x4 __attribute__((ext_vector_type(4)));
typedef unsigned u32x4 __attribute__((ext_vector_type(4)));
constexpr int BM = 256, BK = 64, HALF = 128, HTB = HALF * BK * 2  , STAGE_BYTES = 8 * HTB, NXCD = 8, WGM = 8;

__host__ __device__ __forceinline__ int lds_byte(int r, int c) { const int st = (r >> 4) * 2 + (c >> 5), rr = r & 15, cc = c & 31, ob = rr * 64 + cc * 2; return st * 1024 + (ob ^ (((ob >> 9) & 1) << 5)); }
__host__ __device__ __forceinline__ void stage_rc(int b, int& R, int& C) { const int st = b / 1024, sb = b % 1024, swz = sb ^ (((sb >> 9) & 1) << 5); R = (st >> 1) * 16 + swz / 64; C = (st & 1) * 32 + (swz % 64) / 2; }
__host__ __device__ __forceinline__ int perm32(int rho) { const int n = rho >> 4, i = rho & 15; return 8 * (i >> 2) + 4 * n + (i & 3); }

struct Unit { int pm, pn; };
struct Gemm { const bf16_t* A; const bf16_t* Bt; int M, N, K; };

struct StaticOrder {
    int nM, nN, nwg, G, c;
    __host__ __device__ void init(int M, int N, int G_, int c_) { nM = M / BM; nN = N / BM; nwg = nM * nN; G = G_; c = c_; }
    __host__ __device__ bool next(int i, Unit& u) const {
        const long L = (long)i * G + c; if (L >= nwg) return false;
        int wgid = (int)L; { const int q = nwg / NXCD, r = nwg % NXCD, xcd = wgid % NXCD, off = wgid / NXCD; wgid = (xcd < r ? xcd * (q + 1) : r * (q + 1) + (xcd - r) * q) + off; }
        const int nig = WGM * nN, gid = wgid / nig, fm = gid * WGM, gsz = (nM - fm) < WGM ? (nM - fm) : WGM;
        u.pm = fm + ((wgid % nig) % gsz); u.pn = (wgid % nig) / gsz; return true;
    }
    __device__ __forceinline__ void a_ready(const Unit&) const {}
    __device__ __forceinline__ void done(const Unit&) const {}
};

__device__ __forceinline__ float row_rs(const float* xss, int row) {
    const f32x4 a = *(const f32x4*)(xss + (size_t)row * 4);
    return rsqrtf(((a[0] + a[1]) + (a[2] + a[3])) * (1.0f / 1024.0f) + EPS);
}
struct EpiIn {
    static constexpr bool PERM = true, AFTER_DRAIN = false;
    const float* xss; bf16_t *q, *kP, *vTP, *kS, *vTS, *xbc, *G; float* out; int layer;
    __device__ __forceinline__ void operator()(const f32x4 (&acc)[2][2][4][2], const Unit& u, int wr, int wc, int fr, int fq) const {
        const int l = layer;
        float rsv[2][4];
#pragma unroll
        for (int ai = 0; ai < 2; ++ai)
#pragma unroll
            for (int m = 0; m < 4; ++m) rsv[ai][m] = row_rs(xss, u.pm * BM + ai * HALF + wr * 64 + m * 16 + fr);
#pragma unroll
        for (int ai = 0; ai < 2; ++ai)
#pragma unroll
            for (int m = 0; m < 4; ++m) {
                const int row = u.pm * BM + ai * HALF + wr * 64 + m * 16 + fr;
                const float rs = rsv[ai][m];
                int kind, b, t; float pos;
                if (row < MP) { kind = 0; b = row / LP; t = row - b * LP; pos = (float)t; } else if (row < MV) { kind = 1; b = (row - MP) >> 2; t = (row - MP) & 3; pos = (float)(8192 + t); } else { kind = 2; b = 0; t = 0; pos = 0.f; }
                if (u.pn <= 2) {
                    float cs[4], sn[4];
                    if (u.pn < 2 || true) {
#pragma unroll
                        for (int j = 0; j < 4; ++j) { const int d = 16 * (wc & 1) + 8 * (fq & 1) + 4 * (fq >> 1) + j; const float inv = exp2f(-(float)d * 0.4152410118609203f); const float ang = pos * inv;
                            double rv = (double)ang * 0.15915494309189535; rv -= floor(rv); const float fv = (float)rv; cs[j] = __builtin_amdgcn_cosf(fv); sn[j] = __builtin_amdgcn_sinf(fv); }
                    }
                    if (u.pn < 2) {
#pragma unroll
                        for (int bj = 0; bj < 2; ++bj) { const int head = 4 * u.pn + 2 * bj + (wc >> 1); const f32x4 x1 = acc[ai][bj][m][0] * rs, x2 = acc[ai][bj][m][1] * rs; float o1[4], o2[4];
#pragma unroll
                            for (int j = 0; j < 4; ++j) { o1[j] = (x1[j] * cs[j] - x2[j] * sn[j]) * 0.125f; o2[j] = (x2[j] * cs[j] + x1[j] * sn[j]) * 0.125f; }
                            const unsigned a0 = cvt_pk_bf16(o1[0], o1[1]), a1 = cvt_pk_bf16(o1[2], o1[3]), b0 = cvt_pk_bf16(o2[0], o2[1]), b1 = cvt_pk_bf16(o2[2], o2[3]);
                            const auto rA = __builtin_amdgcn_permlane32_swap(a0, b0, false, false), rB = __builtin_amdgcn_permlane32_swap(a1, b1, false, false);
                            bf16_t* qp = q + (size_t)row * 512 + head * 64 + 16 * (wc & 1) + 8 * (fq & 1) + 32 * (fq >> 1);
                            *(u32x4*)qp = (u32x4){(unsigned)rA[0], (unsigned)rB[0], (unsigned)rA[1], (unsigned)rB[1]}; }
                    } else {
                        const int kvh = wc >> 1, d0 = 16 * (wc & 1) + 8 * (fq & 1) + 4 * (fq >> 1);
                        { const f32x4 x1 = acc[ai][0][m][0] * rs, x2 = acc[ai][0][m][1] * rs; f32x4 o1, o2;
#pragma unroll
                            for (int j = 0; j < 4; ++j) { o1[j] = x1[j] * cs[j] - x2[j] * sn[j]; o2[j] = x2[j] * cs[j] + x1[j] * sn[j]; }
                            const u32x2 w1 = (u32x2){cvt_pk_bf16(o1[0], o1[1]), cvt_pk_bf16(o1[2], o1[3])}, w2 = (u32x2){cvt_pk_bf16(o2[0], o2[1]), cvt_pk_bf16(o2[2], o2[3])};
                            const auto kA = __builtin_amdgcn_permlane32_swap(w1.x, w2.x, false, false), kB = __builtin_amdgcn_permlane32_swap(w1.y, w2.y, false, false);
                            const u32x4 kw = (u32x4){(unsigned)kA[0], (unsigned)kB[0], (unsigned)kA[1], (unsigned)kB[1]}; const int dk = 16 * (wc & 1) + 8 * (fq & 1) + 32 * (fq >> 1);
                            if (kind == 0) { *(u32x4*)(kP + (size_t)row * 128 + kvh * 64 + dk) = kw;
                                if (t >= LP - 128) { float* op = out + OFF_PK + ((size_t)(l * NB + b) * 128 + (t - (LP - 128))) * 128 + kvh * 64 + d0; *(f32x4*)op = o1; *(f32x4*)(op + 32) = o2; } }
                            else if (kind == 1) { *(u32x4*)(kS + ((size_t)(l * SB + b) * KS_ROWS + 128 + t) * 128 + kvh * 64 + dk) = kw;
                                float* op = out + OFF_SK + ((size_t)(l * SB + b) * 128 + 124 + t) * 128 + kvh * 64 + d0; *(f32x4*)op = o1; *(f32x4*)(op + 32) = o2; } }
#pragma unroll
                        for (int n = 0; n < 2; ++n) { const f32x4 v = acc[ai][1][m][n] * rs; const int d = 32 * (wc & 1) + 8 * fq + 4 * n;
                            if (kind == 0) { bf16_t* vp = vTP + ((size_t)(b * 2 + kvh) * 64 + d) * VTP_LD + t;
#pragma unroll
                                for (int j = 0; j < 4; ++j) vp[(size_t)j * VTP_LD] = (bf16_t)(cvt_pk_bf16(v[j], 0.f) & 0xffffu);
                                if (t >= LP - 128) *(f32x4*)(out + OFF_PV + ((size_t)(l * NB + b) * 128 + (t - (LP - 128))) * 128 + kvh * 64 + d) = v; }
                            else if (kind == 1) { bf16_t* vp = vTS + ((size_t)((l * SB + b) * 2 + kvh) * 64 + d) * VTS_LD + 128 + t;
#pragma unroll
                                for (int j = 0; j < 4; ++j) vp[(size_t)j * VTS_LD] = (bf16_t)(cvt_pk_bf16(v[j], 0.f) & 0xffffu);
                                *(f32x4*)(out + OFF_SV + ((size_t)(l * SB + b) * 128 + 124 + t) * 128 + kvh * 64 + d) = v; } }
                    }
                } else if (u.pn <= 4) {
#pragma unroll
                    for (int bj = 0; bj < 2; ++bj) { const f32x4 v0 = acc[ai][bj][m][0] * rs, v1 = acc[ai][bj][m][1] * rs; const int col = 256 * (u.pn - 3) + 128 * bj + 32 * wc + 8 * fq;
                        *(u32x4*)(xbc + (size_t)row * 512 + col) = (u32x4){cvt_pk_bf16(v0[0], v0[1]), cvt_pk_bf16(v0[2], v0[3]), cvt_pk_bf16(v1[0], v1[1]), cvt_pk_bf16(v1[2], v1[3])};
                        if (kind == 0 && t >= LP - 3) { float* op = out + OFF_PC + ((size_t)(l * NB + b) * 3 + (t - (LP - 3))) * 512 + col; *(f32x4*)op = v0; *(f32x4*)(op + 4) = v1; }
                        if (kind == 1 && t >= 1) { float* op = out + OFF_SC + ((size_t)(l * SB + b) * 3 + (t - 1)) * 512 + col; *(f32x4*)op = v0; *(f32x4*)(op + 4) = v1; } }
                } else {
#pragma unroll
                    for (int bj = 0; bj < 2; ++bj) { const f32x4 v0 = acc[ai][bj][m][0] * rs, v1 = acc[ai][bj][m][1] * rs; const int col = 256 * (u.pn - 5) + 128 * bj + 32 * wc + 8 * fq;
                        *(u32x4*)(G + (long)row * 512 + col + (u.pm >= 64 ? G_DELTA : 0)) = (u32x4){cvt_pk_bf16(gelu_tanh(v0[0]), gelu_tanh(v0[1])), cvt_pk_bf16(gelu_tanh(v0[2]), gelu_tanh(v0[3])), cvt_pk_bf16(gelu_tanh(v1[0]), gelu_tanh(v1[1])), cvt_pk_bf16(gelu_tanh(v1[2]), gelu_tanh(v1[3]))}; }
                }
            }
    }
};
struct EpiGU {
    static constexpr bool PERM = true, AFTER_DRAIN = false;
    const float* xss; bf16_t* hact;
    __device__ __forceinline__ void operator()(const f32x4 (&acc)[2][2][4][2], const Unit& u, int wr, int wc, int fr, int fq) const {
        float rsv[2][4];
#pragma unroll
        for (int ai = 0; ai < 2; ++ai)
#pragma unroll
            for (int m = 0; m < 4; ++m) rsv[ai][m] = row_rs(xss, u.pm * BM + ai * HALF + wr * 64 + m * 16 + fr);
#pragma unroll
        for (int ai = 0; ai < 2; ++ai)
#pragma unroll
            for (int m = 0; m < 4; ++m) {
                const int row = u.pm * BM + ai * HALF + wr * 64 + m * 16 + fr; const float rs = rsv[ai][m];
                float h[8];
#pragma unroll
                for (int n = 0; n < 2; ++n)
#pragma unroll
                    for (int j = 0; j < 4; ++j) { const float g = acc[ai][0][m][n][j] * rs, uu = acc[ai][1][m][n][j] * rs; h[4 * n + j] = g * __builtin_amdgcn_rcpf(1.f + __expf(-g)) * uu; }
                { const u32x4 hv4 = (u32x4){cvt_pk_bf16(h[0], h[1]), cvt_pk_bf16(h[2], h[3]), cvt_pk_bf16(h[4], h[5]), cvt_pk_bf16(h[6], h[7])}; bf16_t* hp = hact + (size_t)row * D_FF + 128 * u.pn + 32 * wc + 8 * fq;
                    if (u.pm >= 64) asm volatile("global_store_dwordx4 %0, %1, off sc1\n\ts_nop 1" :: "v"(hp), "v"(hv4) : "memory");
                    else *(u32x4*)hp = hv4; }
            }
    }
};
struct EpiRes {
    static constexpr bool PERM = true, AFTER_DRAIN = true;
    float* out; int final_; bf16_t* xb16; float* xss; const float* gain; unsigned* xbuf; unsigned* cnt; unsigned* ready; unsigned* gdone; const unsigned* xcc_of;
    __device__ __forceinline__ void fused(f32x4 (&acc)[2][2][4][2], const Unit& u, int wr, int wc, int fr, int fq, PG8_LAS unsigned char* lds, int wid, int lane) const {
        PG8_LAS float* P = (PG8_LAS float*)lds;
        PG8_LAS float* S = (PG8_LAS float*)(lds + 4096);
        PG8_LAS float* P2 = (PG8_LAS float*)(lds + 8192);
        const int col0 = u.pn * BM + wc * 32 + 8 * fq;
        u32x4 pre[2][4][2];
#pragma unroll
        for (int ai = 0; ai < 2; ++ai)
#pragma unroll
            for (int m = 0; m < 4; ++m) { const bf16_t* br = xb16 + (size_t)(u.pm * BM + ai * HALF + wr * 64 + m * 16 + fr) * DM + col0;
#pragma unroll
                for (int bj = 0; bj < 2; ++bj) pre[ai][m][bj] = *(const u32x4*)(br + bj * HALF); }
#pragma unroll
        for (int ai = 0; ai < 2; ++ai)
#pragma unroll
            for (int m = 0; m < 4; ++m) { float s = 0.f;
#pragma unroll
                for (int bj = 0; bj < 2; ++bj)
#pragma unroll
                    for (int n = 0; n < 2; ++n) { const f32x4 x = acc[ai][bj][m][n]; s += (x[0] * x[0] + x[1] * x[1]) + (x[2] * x[2] + x[3] * x[3]); }
                s += __shfl_xor(s, 16); s += __shfl_xor(s, 32);
                if (fq == 0) P[(ai * HALF + wr * 64 + m * 16 + fr) * 4 + wc] = s; }
        asm volatile("s_waitcnt lgkmcnt(0)" ::: "memory"); __builtin_amdgcn_s_barrier(); asm volatile("" ::: "memory");
        const int row = wid * 32 + (lane & 31);
        if (lane < 32) { const float tot = (P[row * 4 + 0] + P[row * 4 + 1]) + (P[row * 4 + 2] + P[row * 4 + 3]);
            __hip_atomic_store(xbuf + ((size_t)(u.pm * BM + row) * 4 + u.pn), __float_as_uint(tot), __ATOMIC_RELAXED, __HIP_MEMORY_SCOPE_AGENT); }
        asm volatile("s_waitcnt vmcnt(0)" ::: "memory");
        if (lane == 0) __hip_atomic_fetch_add(cnt + 64 * u.pm, 1u, __ATOMIC_RELAXED, __HIP_MEMORY_SCOPE_AGENT);
        if (wid == 0) { unsigned spins = 0;
            for (;;) { if ((unsigned)__builtin_amdgcn_readfirstlane(__hip_atomic_load(cnt + 64 * u.pm, __ATOMIC_RELAXED, __HIP_MEMORY_SCOPE_AGENT)) >= 32u) break;
                if (++spins > (1u << 22)) break; __builtin_amdgcn_s_sleep(2); } }
        asm volatile("s_waitcnt vmcnt(0) lgkmcnt(0)" ::: "memory"); __builtin_amdgcn_s_barrier(); asm volatile("" ::: "memory");
        if (lane < 32) { const unsigned* sl = xbuf + (size_t)(u.pm * BM + row) * 4; float t = 0.f;
#pragma unroll
            for (int k = 0; k < 4; ++k) t += __uint_as_float(__hip_atomic_load(sl + k, __ATOMIC_RELAXED, __HIP_MEMORY_SCOPE_AGENT));
            S[row] = rsqrtf(t * (1.0f / 1024.0f) + EPS); }
        asm volatile("s_waitcnt lgkmcnt(0)" ::: "memory"); __builtin_amdgcn_s_barrier(); asm volatile("" ::: "memory");
        f32x4 gv[2][2];
#pragma unroll
        for (int bj = 0; bj < 2; ++bj)
#pragma unroll
            for (int n = 0; n < 2; ++n) gv[bj][n] = *(const f32x4*)(gain + col0 + bj * HALF + n * 4);
#pragma unroll
        for (int ai = 0; ai < 2; ++ai)
#pragma unroll
            for (int m = 0; m < 4; ++m) { const int r = ai * HALF + wr * 64 + m * 16 + fr, grow = u.pm * BM + r; const float rstd = S[r];
                bf16_t* br = xb16 + (size_t)grow * DM; float ss = 0.f;
                float* yr = nullptr;
                if (final_) { if (grow < MP) { const int b = grow / LP, t = grow - b * LP; if (t >= NMETA) yr = out + OFF_YP + ((size_t)b * SEQ + (t - NMETA)) * DM; } else if (grow < MV) yr = out + OFF_YS + (size_t)(grow - MP) * DM; }
#pragma unroll
                for (int bj = 0; bj < 2; ++bj) { const int c = col0 + bj * HALF; const u32x4 pb = pre[ai][m][bj];
                    const f32x4 o0 = (f32x4){bflo(pb.x), bfhi(pb.x), bflo(pb.y), bfhi(pb.y)} + acc[ai][bj][m][0] * rstd * gv[bj][0], o1 = (f32x4){bflo(pb.z), bfhi(pb.z), bflo(pb.w), bfhi(pb.w)} + acc[ai][bj][m][1] * rstd * gv[bj][1];
                    if (yr) { *(f32x4*)(yr + c) = o0; *(f32x4*)(yr + c + 4) = o1; }
                    if (!final_) *(u32x4*)(br + c) = (u32x4){cvt_pk_bf16(o0[0], o0[1]), cvt_pk_bf16(o0[2], o0[3]), cvt_pk_bf16(o1[0], o1[1]), cvt_pk_bf16(o1[2], o1[3])};
                    ss += ((o0[0] * o0[0] + o0[1] * o0[1]) + (o0[2] * o0[2] + o0[3] * o0[3])) + ((o1[0] * o1[0] + o1[1] * o1[1]) + (o1[2] * o1[2] + o1[3] * o1[3])); }
                ss += __shfl_xor(ss, 16); ss += __shfl_xor(ss, 32);
                if (fq == 0) P2[r * 4 + wc] = ss; }
        asm volatile("s_waitcnt lgkmcnt(0)" ::: "memory"); __builtin_amdgcn_s_barrier(); asm volatile("" ::: "memory");
        if (lane < 32 && !final_) xss[(size_t)(u.pm * BM + row) * 4 + u.pn] = (P2[row * 4 + 0] + P2[row * 4 + 1]) + (P2[row * 4 + 2] + P2[row * 4 + 3]);
        asm volatile("s_waitcnt vmcnt(0)" ::: "memory"); __builtin_amdgcn_s_barrier(); asm volatile("" ::: "memory");
        if (wid == 0) {
            bool flush = u.pm >= 64 && !final_;
            if (!flush && !final_) { const unsigned my = ((unsigned)__builtin_amdgcn_s_getreg((3 << 11) | 20) & 0xFu) + 1u;
                const unsigned v = lane < 32 ? __hip_atomic_load(xcc_of + 32 * (u.pm >> 3) + lane, __ATOMIC_RELAXED, __HIP_MEMORY_SCOPE_AGENT) : my;
                flush = __builtin_amdgcn_ballot_w64(v != my) != 0ull; }
            if (flush) __builtin_amdgcn_fence(__ATOMIC_RELEASE, "agent");
            asm volatile("s_waitcnt vmcnt(0)" ::: "memory");
            if (lane == 0) { if (u.pm < 64) __hip_atomic_fetch_add(gdone + 64 * ((unsigned)__builtin_amdgcn_s_getreg((3 << 11) | 20) & 0xFu), 8u, __ATOMIC_RELAXED, __HIP_MEMORY_SCOPE_AGENT); else __hip_atomic_fetch_add(ready + 64 * u.pm, 8u, __ATOMIC_RELAXED, __HIP_MEMORY_SCOPE_AGENT); } }
    }
};
__device__ __forceinline__ int tail_owner(int vcu) { const int x = vcu >> 5, j = vcu & 31; return j == 24 ? x : (j == 25 && x < 4) ? 8 + x : -1; }
struct PanelOrder {
    int vcu, round; const unsigned* gcnt;
    __device__ __forceinline__ bool next(int i, Unit& u) const { if (i > 0) return false; if (round == 0) { u.pm = vcu >> 2; u.pn = vcu & 3; return true; }
        const int tu = tail_owner(vcu); if (tu < 0) return false; u.pm = 64 + (tu >> 2); u.pn = tu & 3; return true; }
    __device__ __forceinline__ void a_ready(const Unit& u) const {
        if (gcnt) { if (threadIdx.x < 64) { unsigned polls = 0;
                for (;;) { const unsigned v = (threadIdx.x < 8) ? __hip_atomic_load(gcnt + 64 * threadIdx.x, __ATOMIC_RELAXED, __HIP_MEMORY_SCOPE_AGENT) : 32u;
                    const bool ok = (u.pm < 64) ? ((unsigned)__builtin_amdgcn_readlane((int)v, (vcu >> 5) & 7) >= 32u) : (__builtin_amdgcn_ballot_w64(v < 32u) == 0ull);
                    if (ok) break; if (++polls > (1u << 22)) break; __builtin_amdgcn_s_sleep(2); }
                __builtin_amdgcn_fence(__ATOMIC_ACQUIRE, "agent");
                asm volatile("s_waitcnt vmcnt(0)" ::: "memory"); }
            asm volatile("" ::: "memory"); __builtin_amdgcn_s_barrier(); asm volatile("" ::: "memory"); }
    }
    __device__ __forceinline__ void done(const Unit&) const {}
};
struct GatedOrder {
    int vcu, nN, skip_t; const unsigned* ready; const unsigned* gdone; unsigned need; mutable int waited;
    __device__ __forceinline__ bool next(int i, Unit& u) const {
        const int x = vcu >> 5, j = vcu & 31, nr = (nN + 3) >> 2, tu = tail_owner(vcu);
        if (skip_t == 1 && tu >= 0) return false;
        if (skip_t == 2 && tu >= 0 && i >= nr - 2) return false;
        if (i >= nr) return false;
        const int pn = 4 * i + (j >> 3);
        if (pn < nN) { u.pm = 8 * x + (j & 7); u.pn = pn; return true; }
        if (tu >= 0) return false;
        const int nfree_per = 32 - 8 * (nN & 3), f0 = 32 - nfree_per, nT = x < 4 ? 2 : 1;
        const int lidx = (j - f0) - (j > 24 ? 1 : 0) - ((x < 4 && j > 25) ? 1 : 0);
        if (skip_t && lidx < nT) { u.pm = 8 * x + lidx; u.pn = (skip_t == 2 ? 4 * (nr - 2) : 0) + 3; return true; }
        const int sk = skip_t ? 1 : 0, xm = x < 4 ? x : 4;
        const int t = x * nfree_per - (1 + sk) * (x + xm) + lidx - (skip_t ? nT : 0);
        if (t < 3 * nN) { u.pm = 64 + t / nN; u.pn = t % nN; return true; }
        return false;
    }
    __device__ __forceinline__ void a_ready(const Unit& u) const {
        if (need && (!waited || u.pm >= 64)) { waited = 1; if (threadIdx.x < 64) { unsigned polls = 0;
                for (;;) { unsigned v = (threadIdx.x < 16) ? __hip_atomic_load(gdone + 64 * threadIdx.x, __ATOMIC_RELAXED, __HIP_MEMORY_SCOPE_AGENT) : 0u;
                    v += (unsigned)__builtin_amdgcn_update_dpp(0, (int)v, 0x111, 0xf, 0xf, true); v += (unsigned)__builtin_amdgcn_update_dpp(0, (int)v, 0x112, 0xf, 0xf, true); v += (unsigned)__builtin_amdgcn_update_dpp(0, (int)v, 0x114, 0xf, 0xf, true); v += (unsigned)__builtin_amdgcn_update_dpp(0, (int)v, 0x118, 0xf, 0xf, true);
                    if ((unsigned)__builtin_amdgcn_readlane((int)v, 15) >= 2048u) break; if (++polls > (1u << 22)) break; __builtin_amdgcn_s_sleep(2); }
                if (u.pm >= 64) { while ((unsigned)__builtin_amdgcn_readfirstlane(__hip_atomic_load(ready + 64 * u.pm, __ATOMIC_RELAXED, __HIP_MEMORY_SCOPE_AGENT)) < need) { if (++polls > (1u << 22)) break; __builtin_amdgcn_s_sleep(2); } }
                __builtin_amdgcn_fence(__ATOMIC_ACQUIRE, "agent");
                asm volatile("s_waitcnt vmcnt(0)" ::: "memory"); }
            asm volatile("" ::: "memory"); __builtin_amdgcn_s_barrier(); asm volatile("" ::: "memory"); }
    }
    __device__ __forceinline__ void done(const Unit&) const {}
};
template <class Epi, class Sched, bool ALIGN_EPI = false, bool SP2 = false>
__device__ __forceinline__ void gemm_phase(PG8_LAS unsigned char* lds, const Gemm g, const Sched& S, const Epi& E) {
    int tid_ = threadIdx.x; asm volatile("" : "+v"(tid_));
    const int tid = tid_, wid = __builtin_amdgcn_readfirstlane(tid >> 6), lane = tid & 63, wr = wid >> 2, wc = wid & 3, fr = lane & 15, fq = lane >> 4;
    const int K = g.K, nt = K / BK;
    unsigned voffA[2], voffB[2];
#pragma unroll
    for (int i = 0; i < 2; ++i) { int R, C; stage_rc(tid * 16 + i * 8192, R, C); const int Rb = Epi::PERM ? ((R & ~31) + perm32(R & 31)) : R;
        voffA[i] = (unsigned)(R * K + C) * 2u; voffB[i] = (unsigned)(Rb * K + C) * 2u; }
    const size_t kstep = (size_t)(BK * 2);
    const size_t hstep = (size_t)HALF * K * 2;
    const size_t tstep = 2 * hstep;
    const unsigned ldsw = (unsigned)wid * 1024u;
    const int aoff = lds_byte(wr * 64 + fr, fq * 8), boff = lds_byte(wc * 32 + fr, fq * 8);
#define PG8_SA(b, h) (((b) * 2 + (h)) * HTB)
#define PG8_SB(b, h) ((4 + (b) * 2 + (h)) * HTB)
#define PG8_STAGE(bufoff, gbase, voff) do { _Pragma("unroll") for (int _i = 0; _i < 2; ++_i) \
        __builtin_amdgcn_global_load_lds((const unsigned*)((const char*)(gbase) + (voff)[_i]), (PG8_LAS unsigned*)(lds + (bufoff) + ldsw + _i * 8192), 16, 0, 0); } while (0)
#define PG8_LDA(dst, b, h) do { _Pragma("unroll") for (int m = 0; m < 4; ++m) _Pragma("unroll") for (int k = 0; k < 2; ++k) dst[m][k] = *(const PG8_LAS bf16x8*)(lds + PG8_SA(b, h) + aoff + m * 2048 + k * 1024); } while (0)
#define PG8_LDB(dst, b, h) do { _Pragma("unroll") for (int n = 0; n < 2; ++n) _Pragma("unroll") for (int k = 0; k < 2; ++k) dst[n][k] = *(const PG8_LAS bf16x8*)(lds + PG8_SB(b, h) + boff + n * 2048 + k * 1024); } while (0)
#define PG8_MMA(ai, bj, At, Bt) do { __builtin_amdgcn_s_setprio(1); _Pragma("unroll") for (int m = 0; m < 4; ++m) _Pragma("unroll") for (int n = 0; n < 2; ++n) _Pragma("unroll") for (int k = 0; k < 2; ++k) \
        acc[ai][bj][m][n] = __builtin_amdgcn_mfma_f32_16x16x32_bf16(Bt[n][k], At[m][k], acc[ai][bj][m][n], 0, 0, 0); __builtin_amdgcn_s_setprio(0); } while (0)
#define PG8_WAIT_V(n) asm volatile("s_waitcnt vmcnt(" #n ")" ::: "memory")
#define PG8_WAIT_L(n) asm volatile("s_waitcnt lgkmcnt(" #n ")" ::: "memory")
#define PG8_BAR __builtin_amdgcn_s_barrier()
#define PG8_SCHED __builtin_amdgcn_sched_barrier(0)
    Unit cur, nxt; int ui = 0;
    if (!S.next(0, cur)) return;
    f32x4 acc[2][2][4][2];
#pragma unroll
    for (int a = 0; a < 2; ++a)
#pragma unroll
        for (int b = 0; b < 2; ++b)
#pragma unroll
            for (int m = 0; m < 4; ++m)
#pragma unroll
                for (int n = 0; n < 2; ++n) acc[a][b][m][n] = (f32x4){0.f, 0.f, 0.f, 0.f};
    bf16x8 At[4][2], B0[2][2], B1[2][2];
    const char* cA = (const char*)g.A + (size_t)cur.pm * tstep; const char* cB = (const char*)g.Bt + (size_t)cur.pn * tstep;
    S.a_ready(cur);
    if constexpr (SP2) {
        PG8_STAGE(PG8_SB(0, 0), cB, voffB); PG8_STAGE(PG8_SB(0, 1), cB + hstep, voffB); PG8_STAGE(PG8_SA(0, 0), cA, voffA); PG8_STAGE(PG8_SA(0, 1), cA + hstep, voffA);
        if (wr == 1) PG8_BAR;
        PG8_WAIT_V(2); PG8_BAR;
        PG8_STAGE(PG8_SB(1, 0), cB + kstep, voffB); PG8_STAGE(PG8_SA(1, 0), cA + kstep, voffA); PG8_STAGE(PG8_SB(1, 1), cB + hstep + kstep, voffB);
        PG8_WAIT_V(6); PG8_BAR;
    } else {
        PG8_STAGE(PG8_SB(0, 0), cB, voffB); PG8_STAGE(PG8_SA(0, 0), cA, voffA); PG8_STAGE(PG8_SB(0, 1), cB + hstep, voffB); PG8_STAGE(PG8_SA(0, 1), cA + hstep, voffA);
        if (wr == 1) PG8_BAR;
        PG8_WAIT_V(4); PG8_BAR;
        PG8_STAGE(PG8_SB(1, 0), cB + kstep, voffB); PG8_STAGE(PG8_SA(1, 0), cA + kstep, voffA); PG8_STAGE(PG8_SB(1, 1), cB + hstep + kstep, voffB);
        PG8_WAIT_V(6); PG8_BAR;
    }
    for (;;) {
        const bool has_next = S.next(ui + 1, nxt);
        const char* nA = has_next ? (const char*)g.A + (size_t)nxt.pm * tstep : cA; const char* nB = has_next ? (const char*)g.Bt + (size_t)nxt.pn * tstep : cB;
        for (int t = 0; t < nt; t += 2) {
            const bool last = (t == nt - 2);
            const char* a1 = cA + (size_t)(t + 1) * kstep;
            const char* a2 = last ? nA : cA + (size_t)(t + 2) * kstep; const char* b2 = last ? nB : cB + (size_t)(t + 2) * kstep;
            const char* a3 = a2 + kstep; const char* b3 = b2 + kstep;
            if (last && has_next) S.a_ready(nxt);
            if constexpr (SP2) {
            PG8_LDB(B0, 0, 0); PG8_LDB(B1, 0, 1); PG8_SCHED; PG8_LDA(At, 0, 0); PG8_STAGE(PG8_SA(1, 1), a1 + hstep, voffA);
            PG8_WAIT_V(8); PG8_WAIT_L(0); PG8_BAR; PG8_MMA(0, 0, At, B0); PG8_MMA(0, 1, At, B1); PG8_BAR; PG8_SCHED;
            PG8_LDA(At, 0, 1); PG8_STAGE(PG8_SB(0, 0), b2, voffB); PG8_STAGE(PG8_SB(0, 1), b2 + hstep, voffB); PG8_STAGE(PG8_SA(0, 0), a2, voffA);
            PG8_WAIT_V(8); PG8_WAIT_L(0); PG8_BAR; PG8_MMA(1, 0, At, B0); PG8_MMA(1, 1, At, B1); PG8_BAR; PG8_SCHED;
            PG8_LDB(B0, 1, 0); PG8_LDB(B1, 1, 1); PG8_SCHED; PG8_LDA(At, 1, 0); PG8_STAGE(PG8_SA(0, 1), a2 + hstep, voffA);
            PG8_WAIT_V(8); PG8_WAIT_L(0); PG8_BAR; PG8_MMA(0, 0, At, B0); PG8_MMA(0, 1, At, B1); PG8_BAR; PG8_SCHED;
            PG8_LDA(At, 1, 1); PG8_STAGE(PG8_SB(1, 0), b3, voffB); PG8_STAGE(PG8_SB(1, 1), b3 + hstep, voffB); PG8_STAGE(PG8_SA(1, 0), a3, voffA);
            PG8_WAIT_V(8); PG8_WAIT_L(0); PG8_BAR; PG8_MMA(1, 0, At, B0); PG8_MMA(1, 1, At, B1); PG8_BAR; PG8_SCHED;
            } else {
            PG8_LDB(B0, 0, 0); PG8_SCHED; PG8_LDA(At, 0, 0); PG8_STAGE(PG8_SA(1, 1), a1 + hstep, voffA);
            PG8_WAIT_L(8); PG8_BAR; PG8_WAIT_L(0); PG8_MMA(0, 0, At, B0); PG8_BAR; PG8_SCHED;
            PG8_LDB(B1, 0, 1); PG8_STAGE(PG8_SB(0, 0), b2, voffB);
            PG8_BAR; PG8_WAIT_L(0); PG8_MMA(0, 1, At, B1); PG8_BAR;
            PG8_LDA(At, 0, 1); PG8_STAGE(PG8_SA(0, 0), a2, voffA);
            PG8_BAR; PG8_WAIT_L(0); PG8_MMA(1, 0, At, B0); PG8_BAR; PG8_SCHED;
            PG8_STAGE(PG8_SB(0, 1), b2 + hstep, voffB);
            PG8_WAIT_V(6); PG8_BAR; PG8_MMA(1, 1, At, B1); PG8_BAR;
            PG8_LDB(B0, 1, 0); PG8_SCHED; PG8_LDA(At, 1, 0); PG8_STAGE(PG8_SA(0, 1), a2 + hstep, voffA);
            PG8_WAIT_L(8); PG8_BAR; PG8_WAIT_L(0); PG8_MMA(0, 0, At, B0); PG8_BAR; PG8_SCHED;
            PG8_LDB(B1, 1, 1); PG8_STAGE(PG8_SB(1, 0), b3, voffB);
            PG8_BAR; PG8_WAIT_L(0); PG8_MMA(0, 1, At, B1); PG8_BAR;
            PG8_LDA(At, 1, 1); PG8_STAGE(PG8_SA(1, 0), a3, voffA);
            PG8_BAR; PG8_WAIT_L(0); PG8_MMA(1, 0, At, B0); PG8_BAR; PG8_SCHED;
            PG8_STAGE(PG8_SB(1, 1), b3 + hstep, voffB);
            PG8_WAIT_V(6); PG8_BAR; PG8_MMA(1, 1, At, B1); PG8_BAR;
            }
        }
        if constexpr (ALIGN_EPI) { if (wr == 0) PG8_BAR; }
        if constexpr (!Epi::AFTER_DRAIN) { E(acc, cur, wr, wc, fr, fq); S.done(cur); }
        if (!has_next) break;
#pragma unroll
        for (int a = 0; a < 2; ++a)
#pragma unroll
            for (int b = 0; b < 2; ++b)
#pragma unroll
                for (int m = 0; m < 4; ++m)
#pragma unroll
                    for (int n = 0; n < 2; ++n) acc[a][b][m][n] = (f32x4){0.f, 0.f, 0.f, 0.f};
        cur = nxt; cA = nA; cB = nB; ++ui;
        if constexpr (ALIGN_EPI) { if (wr == 1) PG8_BAR; }
    }
    PG8_WAIT_V(0);
    if constexpr (!ALIGN_EPI) { if (wr == 0) PG8_BAR; }
    PG8_BAR;
    if constexpr (Epi::AFTER_DRAIN) { E.fused(acc, cur, wr, wc, fr, fq, lds, wid, lane); S.done(cur); }
#undef PG8_SA
#undef PG8_SB
#undef PG8_STAGE
#undef PG8_LDA
#undef PG8_LDB
#undef PG8_MMA
#undef PG8_WAIT_V
#undef PG8_WAIT_L
#undef PG8_BAR
#undef PG8_SCHED
}
}
constexpr int NWAVES = 8, NTHREADS = 512, LDS_BYTES = 131072 + 20480;
struct Args { const float* in[26]; float* out; unsigned char* ws; };
struct Ctx {
    unsigned char* lds;
    int tid, lane, wave, vcu, gw;
};
#define OPQ_PTRS unsigned long long ws_i_ = (unsigned long long)A.ws, out_i_ = (unsigned long long)A.out; asm volatile("" : "+s"(ws_i_), "+s"(out_i_)); unsigned char* ws = (unsigned char*)(__attribute__((address_space(1))) unsigned char*)ws_i_; float* out = (float*)(__attribute__((address_space(1))) float*)out_i_
#define IN_XP 0
#define IN_XS 1
#define IN_CK 2
#define IN_CV 3
#define IN_SH 4
#define IN_SC 5
#define IN_META 6
#define IN_PREMIX 7
#define IN_WIN 8
#define IN_SINK 9
#define IN_CONVW 10
#define IN_CONVB 11
#define IN_WA 12
#define IN_BA 13
#define IN_WI 14
#define IN_BI 15
#define IN_LAM 16
#define IN_ATTN_G 17
#define IN_LRU_G 18
#define IN_WOUT 19
#define IN_POSTMIX 20
#define IN_PREFFN 21
#define IN_WGATE 22
#define IN_WUP 23
#define IN_WDOWN 24
#define IN_POSTFFN 25

__device__ __forceinline__ int dest_row(int mode, int c) {
    if (mode == 1) { if (c >= 640) return c; const int d = c & 63, n = d >> 5, w = (d >> 4) & 1, fq = 2 * ((d >> 2) & 1) + ((d >> 3) & 1), j = d & 3; return (c & ~63) + 32 * w + 8 * fq + 4 * n + j; }
    if (mode == 2) return 256 * (c >> 7) + (c & 127);
    if (mode == 3) return 256 * (c >> 7) + 128 + (c & 127);
    return c;
}
__device__ __forceinline__ void transpose_item(const float* W, int K, int N, bf16_t* WT, int mode, const float* g1, const float* g2, float* scr, int item, int lane) {
    const int nblk = N / 32, kb = item / nblk, nb = item % nblk, k0 = 64 * kb, n0 = 32 * nb;
    float wv[32];
#pragma unroll
    for (int i = 0; i < 32; ++i) { const int kk = 2 * i + (lane >> 5); wv[i] = W[(size_t)(k0 + kk) * N + n0 + (lane & 31)]; }
    if (g1) {
#pragma unroll
        for (int i = 0; i < 32; ++i) { const int k = k0 + 2 * i + (lane >> 5); wv[i] *= (k < 512 || !g2) ? g1[k] : g2[k - 512]; } }
#pragma unroll
    for (int i = 0; i < 32; ++i) { const int kk = 2 * i + (lane >> 5); scr[kk * 33 + (lane & 31)] = wv[i]; }
    asm volatile("s_waitcnt lgkmcnt(0)" ::: "memory");
    const int c = lane & 7;
#pragma unroll
    for (int j = 0; j < 4; ++j) { const int n = (lane >> 3) + 8 * j; const float* s = scr + (8 * c) * 33 + n;
        u32x4 o; o.x = cvt_pk_bf16(s[0 * 33], s[1 * 33]); o.y = cvt_pk_bf16(s[2 * 33], s[3 * 33]); o.z = cvt_pk_bf16(s[4 * 33], s[5 * 33]); o.w = cvt_pk_bf16(s[6 * 33], s[7 * 33]);
        *(u32x4*)(WT + (size_t)dest_row(mode, n0 + n) * K + k0 + 8 * c) = o; }
    asm volatile("s_waitcnt lgkmcnt(0)" ::: "memory");
}
__device__ __forceinline__ void p0_prologue(const Args& A, Ctx& C) {
    OPQ_PTRS;
    float* scr = (float*)(C.lds + C.wave * 8448);
    const int NGW = 256 * NWAVES;
    constexpr int I_IN = 16 * 56, I_OUT = 16 * 32, I_G = 16 * 88, I_D = 44 * 32, I_LAYER = I_IN + I_OUT + 2 * I_G + I_D;
    for (int it = C.gw; it < DEPTH * I_LAYER; it += NGW) {
        const int l = it / I_LAYER; int r = it - l * I_LAYER;
        unsigned char* wb = ws + WS_W + (size_t)l * W_LAYER_B;
        if (r < I_IN) { transpose_item(A.in[IN_WIN] + (size_t)l * DM * IN_W, DM, IN_W, (bf16_t*)wb, 1, A.in[IN_PREMIX] + l * DM, nullptr, scr, r, C.lane); continue; } r -= I_IN;
        if (r < I_OUT) { transpose_item(A.in[IN_WOUT] + (size_t)l * DM * DM, DM, DM, (bf16_t*)(wb + W_IN_B), 0, A.in[IN_ATTN_G] + l * 512, A.in[IN_LRU_G] + l * 512, scr, r, C.lane); continue; } r -= I_OUT;
        if (r < I_G) { transpose_item(A.in[IN_WGATE] + (size_t)l * DM * D_FF, DM, D_FF, (bf16_t*)(wb + W_IN_B + W_OUT_B), 2, A.in[IN_PREFFN] + l * DM, nullptr, scr, r, C.lane); continue; } r -= I_G;
        if (r < I_G) { transpose_item(A.in[IN_WUP] + (size_t)l * DM * D_FF, DM, D_FF, (bf16_t*)(wb + W_IN_B + W_OUT_B), 3, A.in[IN_PREFFN] + l * DM, nullptr, scr, r, C.lane); continue; } r -= I_G;
        transpose_item(A.in[IN_WDOWN] + (size_t)l * D_FF * DM, D_FF, DM, (bf16_t*)(wb + W_IN_B + W_OUT_B + W_GU_B), 0, nullptr, nullptr, scr, r, C.lane);
    }
    float* xmeta = (float*)(ws + WS_XMETA); bf16_t* xb16 = (bf16_t*)(ws + WS_XB16); float* xss = (float*)(ws + WS_XSS);
    for (int row0 = C.gw; row0 < MPAD; row0 += 4 * NGW) {
        f32x4 v[4][4]; bool ok[4];
#pragma unroll
        for (int q = 0; q < 4; ++q) { const int row = row0 + q * NGW; ok[q] = row < MPAD; const float* src = nullptr;
            if (row < MP) { const int b = row / LP, t = row - b * LP; src = t < NMETA ? A.in[IN_META] + (size_t)t * DM : A.in[IN_XP] + ((size_t)b * SEQ + (t - NMETA)) * DM; }
            else if (row < MV) src = A.in[IN_XS] + (size_t)(row - MP) * DM;
#pragma unroll
            for (int j = 0; j < 4; ++j) v[q][j] = src ? *((const f32x4*)src + C.lane + 64 * j) : (f32x4){0.f, 0.f, 0.f, 0.f}; }
        float sq[4];
#pragma unroll
        for (int q = 0; q < 4; ++q) { sq[q] = 0.f;
#pragma unroll
            for (int j = 0; j < 4; ++j) { const f32x4 x = v[q][j]; sq[q] += (x[0] * x[0] + x[1] * x[1]) + (x[2] * x[2] + x[3] * x[3]); } }
#pragma unroll
        for (int o = 1; o < 64; o <<= 1) {
#pragma unroll
            for (int q = 0; q < 4; ++q) sq[q] += __shfl_xor(sq[q], o); }
#pragma unroll
        for (int q = 0; q < 4; ++q) { if (!ok[q]) continue; const int row = row0 + q * NGW;
#pragma unroll
            for (int j = 0; j < 4; ++j) *((u32x2*)(xb16 + (size_t)row * DM) + C.lane + 64 * j) = (u32x2){cvt_pk_bf16(v[q][j][0], v[q][j][1]), cvt_pk_bf16(v[q][j][2], v[q][j][3])};
            if (C.lane < 4) xss[(size_t)row * 4 + C.lane] = C.lane == 0 ? sq[q] : 0.f; }
    }
    bf16_t* kS = (bf16_t*)(ws + WS_KS); bf16_t* vTS = (bf16_t*)(ws + WS_VTS);
    bf16_t* vl = (bf16_t*)C.lds;
    for (int lb = C.vcu; lb < DEPTH * SB; lb += 256) {
        __syncthreads();
        const f32x4* ksrc = (const f32x4*)(A.in[IN_CK] + (size_t)lb * 16384); const f32x4* vsrc = (const f32x4*)(A.in[IN_CV] + (size_t)lb * 16384);
        f32x4 kv[8], vv[8];
#pragma unroll
        for (int i = 0; i < 8; ++i) { kv[i] = ksrc[i * 512 + C.tid]; vv[i] = vsrc[i * 512 + C.tid]; }
#pragma unroll
        for (int i = 0; i < 8; ++i) { const int idx = i * 512 + C.tid, j = idx >> 5, c4 = (idx & 31) * 4;
            *(u32x2*)(kS + ((size_t)lb * KS_ROWS + j) * 128 + c4) = (u32x2){cvt_pk_bf16(kv[i][0], kv[i][1]), cvt_pk_bf16(kv[i][2], kv[i][3])};
            const unsigned w0 = cvt_pk_bf16(vv[i][0], vv[i][1]), w1 = cvt_pk_bf16(vv[i][2], vv[i][3]);
            vl[(c4 + 0) * 136 + j] = (bf16_t)(w0 & 0xffffu); vl[(c4 + 1) * 136 + j] = (bf16_t)(w0 >> 16); vl[(c4 + 2) * 136 + j] = (bf16_t)(w1 & 0xffffu); vl[(c4 + 3) * 136 + j] = (bf16_t)(w1 >> 16);
            if (j >= 4) { *(f32x4*)(out + OFF_SK + ((size_t)lb * 128 + j - 4) * 128 + c4) = kv[i]; *(f32x4*)(out + OFF_SV + ((size_t)lb * 128 + j - 4) * 128 + c4) = vv[i]; } }
        __syncthreads();
#pragma unroll
        for (int i = 0; i < 4; ++i) { const int idx = i * 512 + C.tid, c = idx >> 4, j8 = (idx & 15) * 8;
            *(u32x4*)(vTS + ((size_t)lb * 128 + c) * VTS_LD + j8) = *(const u32x4*)(vl + c * 136 + j8); }
    }
    __syncthreads();
    bf16_t* lw = (bf16_t*)(ws + WS_LRUW);
    for (int e = C.gw * 64 + C.lane; e < DEPTH * 8 * 4096; e += NGW * 64) {
        const int i = e & 63, j = (e >> 6) & 63, lh = e >> 12;
        lw[e] = (bf16_t)(cvt_pk_bf16(A.in[IN_WA][(size_t)lh * 4096 + i * 64 + j], 0.f) & 0xffffu);
        lw[DEPTH * 8 * 4096 + e] = (bf16_t)(cvt_pk_bf16(A.in[IN_WI][(size_t)lh * 4096 + i * 64 + j], 0.f) & 0xffffu);
    }
}
#define XB_TMO      128
#define XB_XCNT(j)  (256  + 64 * (j))
#define XB_XSUB(j)  (1280 + 64 * (j))
#define XB_XGEN(j)  (2304 + 64 * (j))
#define XB_TOP      3328
#define XB_TOPGEN   3392
#define XCD_BAR_WORDS 3456
#define XB_SPIN_CAP (1u << 18)

__device__ __forceinline__ unsigned xb_ld(unsigned* p)              { return __hip_atomic_load(p, __ATOMIC_RELAXED, __HIP_MEMORY_SCOPE_AGENT); }
__device__ __forceinline__ unsigned xb_add(unsigned* p, unsigned v) { return __hip_atomic_fetch_add(p, v, __ATOMIC_RELAXED, __HIP_MEMORY_SCOPE_AGENT); }
__device__ __forceinline__ unsigned xb_xcc_id() { return (unsigned)__builtin_amdgcn_s_getreg((3 << 11) | 20) & 0xFu; }
#define XB_SPIN(cond, bar) do { unsigned _sp = 0; while (cond) { __builtin_amdgcn_s_sleep(1); \
    if ((++_sp & 255u) == 0u) { if (xb_ld(&(bar)[XB_TMO])) break; if (_sp > XB_SPIN_CAP) { atomicAdd(&(bar)[XB_TMO], 1u); break; } } } } while (0)

struct XcdBarrier {
    unsigned* bar; unsigned x;
    volatile __attribute__((address_space(3))) unsigned* st;
};

__device__ __forceinline__ XcdBarrier xcd_barrier_post(unsigned* bar, volatile __attribute__((address_space(3))) unsigned* st) {
    XcdBarrier b; b.bar = bar; b.x = xb_xcc_id(); b.st = st;
    if (threadIdx.x == 0) (void)xb_add(&bar[XB_XCNT(b.x)], 1u);
    return b;
}
__device__ __forceinline__ void xcd_barrier_complete(unsigned* bar, unsigned x, unsigned& nloc, unsigned& nx) {
    const unsigned G = gridDim.x * gridDim.y * gridDim.z;
    unsigned sum, cnt, mine, sp = 0u;
    for (;;) {
        sum = 0u; cnt = 0u; mine = 0u;
#pragma unroll
        for (unsigned j = 0; j < 16; ++j) { const unsigned c = xb_ld(&bar[XB_XCNT(j)]); sum += c; cnt += (c > 0u) ? 1u : 0u; mine = (j == x) ? c : mine; }
        if (sum == G) break;
        __builtin_amdgcn_s_sleep(1);
        if ((++sp & 255u) == 0u) { if (xb_ld(&bar[XB_TMO])) break; if (sp > XB_SPIN_CAP) { atomicAdd(&bar[XB_TMO], 1u); break; } }
    }
    nloc = mine > 0u ? mine : 1u; nx = cnt > 0u ? cnt : 1u;
}

__device__ __forceinline__ void xcd_barrier(const XcdBarrier& b) {
    asm volatile("s_waitcnt vmcnt(0)" ::: "memory");
    __syncthreads();
    if (threadIdx.x == 0) {
        unsigned* bar = b.bar;
        __builtin_amdgcn_s_waitcnt(0);
        unsigned nloc = b.st[0], nx = b.st[1];
        if (nloc == 0u) { xcd_barrier_complete(bar, b.x, nloc, nx); b.st[0] = nloc; b.st[1] = nx; }
        const unsigned old = xb_add(&bar[XB_XSUB(b.x)], 1u);
        const unsigned gen = old / nloc;
        if (old + 1u == (gen + 1u) * nloc) {
            __builtin_amdgcn_fence(__ATOMIC_RELEASE, "agent");
            asm volatile("s_waitcnt vmcnt(0)" ::: "memory");
            const unsigned og = xb_add(&bar[XB_TOP], 1u);
            const unsigned tg = og / nx;
            if (og + 1u == (tg + 1u) * nx) xb_add(&bar[XB_TOPGEN], 1u);
            else XB_SPIN(xb_ld(&bar[XB_TOPGEN]) == tg, bar);
            __builtin_amdgcn_fence(__ATOMIC_ACQUIRE, "agent");
            xb_add(&bar[XB_XGEN(b.x)], 1u);
            asm volatile("s_waitcnt vmcnt(0)" ::: "memory");
        } else {
            XB_SPIN(xb_ld(&bar[XB_XGEN(b.x)]) == gen, bar);
            __builtin_amdgcn_fence(__ATOMIC_ACQUIRE, "agent");
            asm volatile("s_waitcnt vmcnt(0)" ::: "memory");
        }
    }
    __syncthreads();
}
__device__ __forceinline__ void attn_item(const Args& A, Ctx& C, unsigned char* ws, float* out, int l, int it) {
    const int lane = C.lane, n = lane & 15, kq = lane >> 4;
    const bf16_t* Q = (const bf16_t*)(ws + WS_Q); bf16_t* O = (bf16_t*)(ws + WS_MRG);
    int tq, head, qrow, kt_hi, kstride_v; const bf16_t* Kb; const bf16_t* Vb;
    if (it < NB * 129 * 8) { const int h = it & 7, qt = (it >> 3) % 129, b = (it >> 3) / 129; tq = 16 * qt + n; head = h; qrow = b * LP + tq; kt_hi = qt;
        Kb = (const bf16_t*)(ws + WS_KP) + (size_t)b * LP * 128 + (h >> 2) * 64; Vb = (const bf16_t*)(ws + WS_VTP) + (size_t)(b * 2 + (h >> 2)) * 64 * VTP_LD; kstride_v = VTP_LD; }
    else { const int i2 = it - NB * 129 * 8, g = i2 & 1, bs = i2 >> 1; tq = 128 + (n & 3); head = 4 * g + (n >> 2); qrow = MP + bs * 4 + (n & 3); kt_hi = 8;
        Kb = (const bf16_t*)(ws + WS_KS) + (size_t)(l * SB + bs) * KS_ROWS * 128 + g * 64; Vb = (const bf16_t*)(ws + WS_VTS) + (size_t)((l * SB + bs) * 2 + g) * 64 * VTS_LD; kstride_v = VTS_LD; }
    const bf16x8 q0 = *(const bf16x8*)(Q + (size_t)qrow * 512 + head * 64 + 8 * kq), q1 = *(const bf16x8*)(Q + (size_t)qrow * 512 + head * 64 + 32 + 8 * kq);
    const float sink = A.in[IN_SINK][l * 8 + head];
    u32x2 vfa[5][4], vfb[5][4];
#pragma unroll
    for (int pr = 0; pr < 5; ++pr) { int kta = kt_hi - 8 + 2 * pr - 1, ktb = kt_hi - 8 + 2 * pr; kta = kta < 0 ? 0 : kta; ktb = ktb < 0 ? 0 : ktb;
#pragma unroll
        for (int dt = 0; dt < 4; ++dt) { const bf16_t* vp = Vb + (size_t)(16 * dt + n) * kstride_v + 4 * kq; vfa[pr][dt] = *(const u32x2*)(vp + 16 * kta); vfb[pr][dt] = *(const u32x2*)(vp + 16 * ktb); } }
    f32x4 s[9]; float mx = sink;
#pragma unroll
    for (int T = 0; T < 9; ++T) { const int kt = kt_hi - 8 + T; s[T] = (f32x4){0.f, 0.f, 0.f, 0.f};
        if (kt >= 0) { const bf16_t* kp = Kb + (size_t)(16 * kt + n) * 128 + 8 * kq; const bf16x8 k0 = *(const bf16x8*)kp, k1 = *(const bf16x8*)(kp + 32);
            s[T] = __builtin_amdgcn_mfma_f32_16x16x32_bf16(k0, q0, s[T], 0, 0, 0); s[T] = __builtin_amdgcn_mfma_f32_16x16x32_bf16(k1, q1, s[T], 0, 0, 0); }
#pragma unroll
        for (int j = 0; j < 4; ++j) { const int key = 16 * kt + 4 * kq + j; const bool ok = (key >= 0) && (key <= tq) && (key > tq - 128); s[T][j] = ok ? s[T][j] : -INFINITY; mx = fmaxf(mx, s[T][j]); } }
    mx = fmaxf(mx, __shfl_xor(mx, 16)); mx = fmaxf(mx, __shfl_xor(mx, 32));
    float sum = 0.f; u32x2 pk[9];
#pragma unroll
    for (int T = 0; T < 9; ++T) { float p[4];
#pragma unroll
        for (int j = 0; j < 4; ++j) { p[j] = __expf(s[T][j] - mx); sum += p[j]; }
        pk[T] = (u32x2){cvt_pk_bf16(p[0], p[1]), cvt_pk_bf16(p[2], p[3])}; }
    sum += __shfl_xor(sum, 16); sum += __shfl_xor(sum, 32);
    sum += __expf(sink - mx);
    const float rl = __builtin_amdgcn_rcpf(sum);
    f32x4 o[4];
#pragma unroll
    for (int dt = 0; dt < 4; ++dt) o[dt] = (f32x4){0.f, 0.f, 0.f, 0.f};
#pragma unroll
    for (int pr = 0; pr < 5; ++pr) { const int Ta = 2 * pr - 1, Tb = 2 * pr;
        const u32x2 pa = Ta >= 0 ? pk[Ta < 0 ? 0 : Ta] : (u32x2){0u, 0u}, pb = pk[Tb];
        const bf16x8 pf = __builtin_bit_cast(bf16x8, (u32x4){pa.x, pa.y, pb.x, pb.y});
#pragma unroll
        for (int dt = 0; dt < 4; ++dt) { const bf16x8 vf = __builtin_bit_cast(bf16x8, (u32x4){vfa[pr][dt].x, vfa[pr][dt].y, vfb[pr][dt].x, vfb[pr][dt].y});
            o[dt] = __builtin_amdgcn_mfma_f32_16x16x32_bf16(vf, pf, o[dt], 0, 0, 0); } }
#pragma unroll
    for (int dt = 0; dt < 4; ++dt) *(u32x2*)(O + (size_t)qrow * DM + head * 64 + 16 * dt + 4 * kq) = (u32x2){cvt_pk_bf16(o[dt][0] * rl, o[dt][1] * rl), cvt_pk_bf16(o[dt][2] * rl, o[dt][3] * rl)};
}
__device__ __forceinline__ void lru_item(const Args& A, Ctx& C, unsigned char* ws, float* out, int l, int it, const unsigned char* wl, const float* cwl) {
    const int lane = C.lane, fr = lane & 15, kq = lane >> 4;
    const bool samp = it >= NB * NCH * 8;
    int blk, b, c, rowbase;
    if (it < 2048) { blk = it & 7; c = (it >> 3) & 31; b = it >> 8; rowbase = b * LP + 64 * c; }
    else if (!samp) { blk = it & 7; c = NCH - 1; b = (it - 2048) >> 3; rowbase = b * LP + 64 * c; }
    else { const int i2 = it - NB * NCH * 8; blk = i2 & 7; c = i2 >> 3; b = 0; rowbase = MP + 16 * c; }
    const bf16_t* XBC = (const bf16_t*)(ws + WS_XBC); bf16_t* MRG = (bf16_t*)(ws + WS_MRG); bf16_t* PL = (bf16_t*)(ws + WS_PL);
    float ba[4], bi[4], lsl[4], h0v[4];
#pragma unroll
    for (int nt = 0; nt < 4; ++nt) { ba[nt] = cwl[320 + 16 * nt + fr]; bi[nt] = cwl[384 + 16 * nt + fr]; lsl[nt] = cwl[448 + 16 * nt + fr];
        h0v[nt] = samp ? A.in[IN_SH][(size_t)(l * SB + 4 * c + kq) * 512 + 64 * blk + 16 * nt + fr] : 0.f; }
    const float* cw = cwl; const float* cb = cwl + 256;
    float Pc[4], Hc[4];
#pragma unroll
    for (int nt = 0; nt < 4; ++nt) { Pc[nt] = 1.f; Hc[nt] = 0.f; }
    const int nvalid = samp ? 16 : (LP - 64 * c < 64 ? LP - 64 * c : 64);
    u32x4 xcur[2], xprev[2], xnext[2];
#pragma unroll
    for (int ks = 0; ks < 2; ++ks) { xcur[ks] = xprev[ks] = xnext[ks] = (u32x4){0u, 0u, 0u, 0u}; }
    if (!samp) {
#pragma unroll
        for (int ks = 0; ks < 2; ++ks) { const int tp = 64 * c - 16 + fr; if (tp >= 0) xprev[ks] = *(const u32x4*)(XBC + (size_t)(b * LP + tp) * 512 + 64 * blk + 32 * ks + 8 * kq);
            const int t = 64 * c + fr; if (t < LP) xcur[ks] = *(const u32x4*)(XBC + (size_t)(b * LP + t) * 512 + 64 * blk + 32 * ks + 8 * kq); }
    }
#pragma unroll 1
    for (int m = 0; m < 4; ++m) {
        if (16 * m >= nvalid) break;
        if (!samp) {
#pragma unroll
            for (int ks = 0; ks < 2; ++ks) { const int t = 64 * c + 16 * (m + 1) + fr; xnext[ks] = (m < 3 && t < LP) ? *(const u32x4*)(XBC + (size_t)(b * LP + t) * 512 + 64 * blk + 32 * ks + 8 * kq) : (u32x4){0u, 0u, 0u, 0u}; }
        }
        const int ra = 16 * m + fr; bf16x8 ua[2];
#pragma unroll
        for (int ks = 0; ks < 2; ++ks) { const int ch0 = 32 * ks + 8 * kq; float uv[8];
            { const f32x4 b0 = *(const f32x4*)(cb + ch0), b1 = *(const f32x4*)(cb + ch0 + 4); uv[0] = b0[0]; uv[1] = b0[1]; uv[2] = b0[2]; uv[3] = b0[3]; uv[4] = b1[0]; uv[5] = b1[1]; uv[6] = b1[2]; uv[7] = b1[3]; }
            if (!samp) {
                const u32x4 cur = xcur[ks], prv = xprev[ks];
#pragma unroll
                for (int sft = 0; sft < 4; ++sft) { const int j = 3 - sft; const f32x4 w0 = *(const f32x4*)(cw + j * 64 + ch0), w1 = *(const f32x4*)(cw + j * 64 + ch0 + 4); u32x4 v = cur;
                    if (sft > 0) {
#pragma unroll
                        for (int d = 0; d < 4; ++d) { const int cr = sft == 1 ? __builtin_amdgcn_update_dpp(0, (int)cur[d], 0x121, 0xf, 0xf, false) : sft == 2 ? __builtin_amdgcn_update_dpp(0, (int)cur[d], 0x122, 0xf, 0xf, false) : __builtin_amdgcn_update_dpp(0, (int)cur[d], 0x123, 0xf, 0xf, false);
                            const int pr = sft == 1 ? __builtin_amdgcn_update_dpp(0, (int)prv[d], 0x121, 0xf, 0xf, false) : sft == 2 ? __builtin_amdgcn_update_dpp(0, (int)prv[d], 0x122, 0xf, 0xf, false) : __builtin_amdgcn_update_dpp(0, (int)prv[d], 0x123, 0xf, 0xf, false);
                            v[d] = (unsigned)(fr >= sft ? cr : pr); } }
                    uv[0] += bflo(v.x) * w0[0]; uv[1] += bfhi(v.x) * w0[1]; uv[2] += bflo(v.y) * w0[2]; uv[3] += bfhi(v.y) * w0[3]; uv[4] += bflo(v.z) * w1[0]; uv[5] += bfhi(v.z) * w1[1]; uv[6] += bflo(v.w) * w1[2]; uv[7] += bfhi(v.w) * w1[3]; }
            } else {
#pragma unroll
                for (int j = 0; j < 4; ++j) { const f32x4 w0 = *(const f32x4*)(cw + j * 64 + ch0), w1 = *(const f32x4*)(cw + j * 64 + ch0 + 4); float xv[8];
                    const int sr = 16 * c + ra, bs = sr >> 2, tau = (sr & 3) + j - 3;
                    if (tau >= 0) { const u32x4 r = *(const u32x4*)(XBC + (size_t)(MP + bs * 4 + tau) * 512 + 64 * blk + ch0);
                        xv[0] = bflo(r.x); xv[1] = bfhi(r.x); xv[2] = bflo(r.y); xv[3] = bfhi(r.y); xv[4] = bflo(r.z); xv[5] = bfhi(r.z); xv[6] = bflo(r.w); xv[7] = bfhi(r.w); }
                    else { const float* sp = A.in[IN_SC] + ((size_t)(l * SB + bs) * 3 + (tau + 3)) * 512 + 64 * blk + ch0; const f32x4 r0 = *(const f32x4*)sp, r1 = *(const f32x4*)(sp + 4);
                        xv[0] = r0[0]; xv[1] = r0[1]; xv[2] = r0[2]; xv[3] = r0[3]; xv[4] = r1[0]; xv[5] = r1[1]; xv[6] = r1[2]; xv[7] = r1[3]; }
                    uv[0] += xv[0] * w0[0]; uv[1] += xv[1] * w0[1]; uv[2] += xv[2] * w0[2]; uv[3] += xv[3] * w0[3]; uv[4] += xv[4] * w1[0]; uv[5] += xv[5] * w1[1]; uv[6] += xv[6] * w1[2]; uv[7] += xv[7] * w1[3]; }
            }
            ua[ks] = __builtin_bit_cast(bf16x8, (u32x4){cvt_pk_bf16(uv[0], uv[1]), cvt_pk_bf16(uv[2], uv[3]), cvt_pk_bf16(uv[4], uv[5]), cvt_pk_bf16(uv[6], uv[7])}); }
#pragma unroll
        for (int nt = 0; nt < 4; ++nt) {
            f32x4 ga = (f32x4){0.f, 0.f, 0.f, 0.f}, gi = ga, gu = ga;
            const int wrow = 16 * nt + fr, wsw = wrow & 7; const unsigned char* wr_ = wl + wrow * 128;
            const bf16x8 wa0 = *(const bf16x8*)(wr_ + ((kq ^ wsw) << 4)), wa1 = *(const bf16x8*)(wr_ + (((4 + kq) ^ wsw) << 4)), wi0 = *(const bf16x8*)(wr_ + 8192 + ((kq ^ wsw) << 4)), wi1 = *(const bf16x8*)(wr_ + 8192 + (((4 + kq) ^ wsw) << 4));
            ga = __builtin_amdgcn_mfma_f32_16x16x32_bf16(ua[0], wa0, ga, 0, 0, 0); ga = __builtin_amdgcn_mfma_f32_16x16x32_bf16(ua[1], wa1, ga, 0, 0, 0);
            gi = __builtin_amdgcn_mfma_f32_16x16x32_bf16(ua[0], wi0, gi, 0, 0, 0); gi = __builtin_amdgcn_mfma_f32_16x16x32_bf16(ua[1], wi1, gi, 0, 0, 0);
            {
                const bool on = kq == ((16 * (nt & 1) + fr) >> 3); const int e = fr & 7; u32x4 idw = (u32x4){0u, 0u, 0u, 0u};
                const unsigned one = (e & 1) ? 0x3f800000u : 0x00003f80u;
                if (on) { if ((e >> 1) == 0) idw.x = one; else if ((e >> 1) == 1) idw.y = one; else if ((e >> 1) == 2) idw.z = one; else idw.w = one; }
                gu = __builtin_amdgcn_mfma_f32_16x16x32_bf16(ua[nt >> 1], __builtin_bit_cast(bf16x8, idw), gu, 0, 0, 0); }
            float av[4], bv[4];
#pragma unroll
            for (int j = 0; j < 4; ++j) { const float r = sigmoidf_(ga[j] + ba[nt]), ig = sigmoidf_(gi[j] + bi[nt]); const float la = r * lsl[nt];
                av[j] = __expf(la); { const float x2 = 2.f * la; const float ser = -x2 * (1.f + x2 * (0.5f + x2 * (0.16666667f + x2 * (0.041666668f + x2 * 0.0083333338f)))); const float alt = __builtin_fmaf(-av[j], av[j], 1.f); const float om = x2 > -0.125f ? ser : alt; bv[j] = __builtin_amdgcn_sqrtf(om) * ig * gu[j]; }
                if (nvalid < 16 * m + 16 && 16 * m + 4 * kq + j >= nvalid) { av[j] = 1.f; bv[j] = 0.f; } }
            float Pj[4], Hj[4];
            if (!samp) {
                Pj[0] = av[0]; Hj[0] = bv[0];
#pragma unroll
                for (int j = 1; j < 4; ++j) { Pj[j] = av[j] * Pj[j - 1]; Hj[j] = av[j] * Hj[j - 1] + bv[j]; }
                float A = Pj[3], B = Hj[3];
                { const float Ap = __shfl_up(A, 16), Bp = __shfl_up(B, 16); if (kq >= 1) { B = A * Bp + B; A = A * Ap; } }
                { const float Ap = __shfl_up(A, 32), Bp = __shfl_up(B, 32); if (kq >= 2) { B = A * Bp + B; A = A * Ap; } }
                float Ae = __shfl_up(A, 16), Be = __shfl_up(B, 16); if (kq == 0) { Ae = 1.f; Be = 0.f; }
                const float A3 = __shfl(A, 48 + fr), B3 = __shfl(B, 48 + fr);
                const float cp = Ae * Pc[nt], chh = Be + Ae * Hc[nt];
#pragma unroll
                for (int j = 0; j < 4; ++j) { Hj[j] = Hj[j] + Pj[j] * chh; Pj[j] = Pj[j] * cp; }
                Hc[nt] = A3 * Hc[nt] + B3; Pc[nt] = A3 * Pc[nt];
            } else {
                const int bs = (16 * c + 16 * m) / 4 + kq; const int ch = 64 * blk + 16 * nt + fr;
                float h = h0v[nt];
#pragma unroll
                for (int j = 0; j < 4; ++j) { h = av[j] * h + bv[j]; Hj[j] = h; Pj[j] = 0.f; }
                out[OFF_SH + (size_t)(l * SB + bs) * 512 + ch] = h;
            }

            { const int rr0 = 16 * m + 4 * kq; const int ch = 64 * blk + 16 * nt + fr; bf16_t* mp = MRG + ((size_t)rowbase + rr0) * DM + 512 + ch; bf16_t* pp = PL + ((size_t)rowbase + rr0) * 512 + ch;
                if (nvalid >= 16 * m + 16) {
#pragma unroll
                    for (int j = 0; j < 4; ++j) { mp[j * DM] = (bf16_t)(cvt_pk_bf16(Hj[j], 0.f) & 0xffffu); pp[j * 512] = (bf16_t)(cvt_pk_bf16(Pj[j], 0.f) & 0xffffu); } }
                else {
#pragma unroll
                    for (int j = 0; j < 4; ++j) if (rr0 + j < nvalid) { mp[j * DM] = (bf16_t)(cvt_pk_bf16(Hj[j], 0.f) & 0xffffu); pp[j * 512] = (bf16_t)(cvt_pk_bf16(Pj[j], 0.f) & 0xffffu); } } }
        }
#pragma unroll
        for (int ks = 0; ks < 2; ++ks) { xprev[ks] = xcur[ks]; xcur[ks] = xnext[ks]; }
    }
    if (!samp && kq == 0) { float* agg = (float*)(ws + WS_AGG) + ((size_t)(b * NCH + c) * 512 + 64 * blk) * 2;
#pragma unroll
        for (int nt = 0; nt < 4; ++nt) *(f32x2*)(agg + (16 * nt + fr) * 2) = (f32x2){Pc[nt], Hc[nt]}; }
}
constexpr int KL_LD = 136, VL_LD = 200, VL_OFF = 192 * KL_LD * 2;
__device__ __forceinline__ void attn_wg_item(const Args& A, Ctx& C, unsigned char* ws, float* out, int l, int it) {
    const int lane = C.lane, n = lane & 15, kq = lane >> 4, h = C.wave, kvh = h >> 2;
    const int b = it / NCH, qt = it - b * NCH, t0 = 64 * qt, kbase = t0 - 128, nsub = (LP - t0 < 64 ? LP - t0 : 64) >> 4;
    const bf16_t* Q = (const bf16_t*)(ws + WS_Q); bf16_t* O = (bf16_t*)(ws + WS_MRG);
    const bf16_t* kP = (const bf16_t*)(ws + WS_KP) + (size_t)b * LP * 128; const bf16_t* vT = (const bf16_t*)(ws + WS_VTP) + (size_t)b * 128 * VTP_LD;
    bf16_t* Kl = (bf16_t*)C.lds; bf16_t* Vl = (bf16_t*)(C.lds + VL_OFF);
    bf16x8 qf[4][2];
#pragma unroll
    for (int sub = 0; sub < 4; ++sub) { const int tq = t0 + 16 * sub + n; const bool ok = tq < LP; const bf16_t* qp = Q + (size_t)(b * LP + (ok ? tq : 0)) * 512 + h * 64 + 8 * kq;
        qf[sub][0] = *(const bf16x8*)qp; qf[sub][1] = *(const bf16x8*)(qp + 32); }
    {
        u32x4 kr[6], vr[6];
#pragma unroll
        for (int i = 0; i < 6; ++i) { const int idx = i * 512 + C.tid; const int row = idx >> 4, ch8 = (idx & 15) * 8, t = kbase + row;
            kr[i] = (t >= 0 && t < LP) ? *(const u32x4*)(kP + (size_t)t * 128 + ch8) : (u32x4){0u, 0u, 0u, 0u};
            const int drow = idx / 24, ck = idx - drow * 24, tv = kbase + 8 * ck;
            vr[i] = tv >= 0 ? *(const u32x4*)(vT + (size_t)drow * VTP_LD + tv) : (u32x4){0u, 0u, 0u, 0u}; }
#pragma unroll
        for (int i = 0; i < 6; ++i) { const int idx = i * 512 + C.tid; const int row = idx >> 4, ch8 = (idx & 15) * 8; *(u32x4*)(Kl + row * KL_LD + ch8) = kr[i];
            const int drow = idx / 24, ck = idx - drow * 24; *(u32x4*)(Vl + drow * VL_LD + 8 * ck) = vr[i]; }
    }
    __syncthreads();
    const float sink = A.in[IN_SINK][l * 8 + h];
    for (int sub = 0; sub < nsub; ++sub) {
        const int tq = t0 + 16 * sub + n; const size_t qrow = (size_t)b * LP + tq;
        const bf16x8 q0 = sub == 0 ? qf[0][0] : sub == 1 ? qf[1][0] : sub == 2 ? qf[2][0] : qf[3][0], q1 = sub == 0 ? qf[0][1] : sub == 1 ? qf[1][1] : sub == 2 ? qf[2][1] : qf[3][1];
        f32x4 s[9]; float mx = sink;
#pragma unroll
        for (int T = 0; T < 9; ++T) { const bf16_t* kp = Kl + (16 * (sub + T) + n) * KL_LD + kvh * 64 + 8 * kq; const bf16x8 k0 = *(const bf16x8*)kp, k1 = *(const bf16x8*)(kp + 32);
            s[T] = (f32x4){0.f, 0.f, 0.f, 0.f};
            s[T] = __builtin_amdgcn_mfma_f32_16x16x32_bf16(k0, q0, s[T], 0, 0, 0); s[T] = __builtin_amdgcn_mfma_f32_16x16x32_bf16(k1, q1, s[T], 0, 0, 0);
#pragma unroll
            for (int j = 0; j < 4; ++j) { const int key = kbase + 16 * (sub + T) + 4 * kq + j; const bool ok = (key >= 0) && (key <= tq) && (key > tq - 128); s[T][j] = ok ? s[T][j] : -INFINITY; mx = fmaxf(mx, s[T][j]); } }
        mx = fmaxf(mx, __shfl_xor(mx, 16)); mx = fmaxf(mx, __shfl_xor(mx, 32));
        float sum = 0.f; u32x2 pk[9];
#pragma unroll
        for (int T = 0; T < 9; ++T) { float p[4];
#pragma unroll
            for (int j = 0; j < 4; ++j) { p[j] = __expf(s[T][j] - mx); sum += p[j]; }
            pk[T] = (u32x2){cvt_pk_bf16(p[0], p[1]), cvt_pk_bf16(p[2], p[3])}; }
        sum += __shfl_xor(sum, 16); sum += __shfl_xor(sum, 32);
        sum += __expf(sink - mx);
        const float rl = __builtin_amdgcn_rcpf(sum);
        f32x4 o[4];
#pragma unroll
        for (int dt = 0; dt < 4; ++dt) o[dt] = (f32x4){0.f, 0.f, 0.f, 0.f};
#pragma unroll
        for (int pr = 0; pr < 5; ++pr) { const int Ta = 2 * pr - 1, Tb = 2 * pr;
            const u32x2 pa = Ta >= 0 ? pk[Ta < 0 ? 0 : Ta] : (u32x2){0u, 0u}, pb = pk[Tb];
            const bf16x8 pf = __builtin_bit_cast(bf16x8, (u32x4){pa.x, pa.y, pb.x, pb.y});
#pragma unroll
            for (int dt = 0; dt < 4; ++dt) { const bf16_t* vp = Vl + (kvh * 64 + 16 * dt + n) * VL_LD + 4 * kq;
                const u32x2 va = *(const u32x2*)(vp + 16 * (sub + (Ta < 0 ? 0 : Ta))), vb = *(const u32x2*)(vp + 16 * (sub + Tb));
                const bf16x8 vf = __builtin_bit_cast(bf16x8, (u32x4){va.x, va.y, vb.x, vb.y});
                o[dt] = __builtin_amdgcn_mfma_f32_16x16x32_bf16(vf, pf, o[dt], 0, 0, 0); } }
#pragma unroll
        for (int dt = 0; dt < 4; ++dt) *(u32x2*)(O + qrow * DM + h * 64 + 16 * dt + 4 * kq) = (u32x2){cvt_pk_bf16(o[dt][0] * rl, o[dt][1] * rl), cvt_pk_bf16(o[dt][2] * rl, o[dt][3] * rl)};
    }
    __syncthreads();
}
__device__ __forceinline__ void p2_mixer(const Args& A, Ctx& C, int l) {
    OPQ_PTRS; asm volatile("" : "+s"(l)); asm volatile("" : "+v"(C.lane), "+v"(C.tid));
    constexpr int N_LRU = NB * NCH * 8 + 32 * 8, N_ATTP = NB * 129 * 8, N_SAMP = SB * 2;
    for (int it = C.vcu; it < NB * NCH; it += 256) attn_wg_item(A, C, ws, out, l, it);
    unsigned char* wl = C.lds + C.wave * 16384; float* cwl = (float*)(C.lds + 131072 + 64 + C.wave * 2304);
    { const int blk = C.wave; const bf16_t* lwA = (const bf16_t*)(ws + WS_LRUW) + (size_t)(l * 8 + blk) * 4096; const bf16_t* lwI = lwA + DEPTH * 8 * 4096;
        u32x4 ta[8], ti[8];
#pragma unroll
        for (int i = 0; i < 8; ++i) { ta[i] = *((const u32x4*)lwA + i * 64 + C.lane); ti[i] = *((const u32x4*)lwI + i * 64 + C.lane); }
        float cv[5];
#pragma unroll
        for (int j = 0; j < 4; ++j) cv[j] = A.in[IN_CONVW][(size_t)l * 4 * 512 + j * 512 + 64 * blk + C.lane];
        cv[4] = A.in[IN_CONVB][l * 512 + 64 * blk + C.lane];
    const float sba = A.in[IN_BA][l * 512 + 64 * blk + C.lane], sbi = A.in[IN_BI][l * 512 + 64 * blk + C.lane], slm = A.in[IN_LAM][l * 512 + 64 * blk + C.lane];
#pragma unroll
        for (int i = 0; i < 8; ++i) { const int idx = i * 64 + C.lane, row = idx >> 3, ch = idx & 7; *(u32x4*)(wl + row * 128 + ((ch ^ (row & 7)) << 4)) = ta[i]; *(u32x4*)(wl + 8192 + row * 128 + ((ch ^ (row & 7)) << 4)) = ti[i]; }
#pragma unroll
        for (int j = 0; j < 5; ++j) cwl[j * 64 + C.lane] = cv[j];
    cwl[320 + C.lane] = sba; cwl[384 + C.lane] = sbi; cwl[448 + C.lane] = 8.0f * (fminf(slm, 0.f) - log1pf(__expf(-fabsf(slm))));
        asm volatile("s_waitcnt lgkmcnt(0)" ::: "memory"); }
    for (int it = (255 - C.vcu) * NWAVES + C.wave; it < N_LRU + N_SAMP; it += 256 * NWAVES) { if (it < N_LRU) lru_item(A, C, ws, out, l, it, wl, cwl); else attn_item(A, C, ws, out, l, N_ATTP + it - N_LRU); }
    __syncthreads();
}
__device__ __forceinline__ void p3_fixup(const Args& A, Ctx& C, int l) {
    OPQ_PTRS; asm volatile("" : "+s"(l)); asm volatile("" : "+v"(C.lane), "+v"(C.tid));
    float* hin = (float*)C.lds; bf16_t* MRG = (bf16_t*)(ws + WS_MRG); const bf16_t* PL = (const bf16_t*)(ws + WS_PL); const bf16_t* G = (const bf16_t*)(ws + WS_G);
    const float* agg = (const float*)(ws + WS_AGG);
    for (int it = C.vcu; it < NB * NCH + 8 + 2; it += 256) {
        __syncthreads();
        if (it >= NB * NCH + 8) {
            const int r0 = MV + 64 * (it - NB * NCH - 8);
            for (int e = C.tid; e < 64 * 128; e += NTHREADS) *((u32x4*)(MRG + (size_t)r0 * DM) + e) = (u32x4){0u, 0u, 0u, 0u};
            continue; }
        const bool samp = it >= NB * NCH;
        int b, c; if (it < 256) { b = it >> 5; c = it & 31; } else { b = it - 256; c = NCH - 1; }
        const int rowbase = samp ? MP + 64 * (it - NB * NCH) : b * LP + 64 * c; const int nvalid = samp ? 64 : (LP - 64 * c < 64 ? LP - 64 * c : 64);
        float h = 0.f;
        if (!samp) { const f32x2* ap = (const f32x2*)agg + (size_t)b * NCH * 512 + C.tid;
            for (int c0 = 0; c0 < c; c0 += 8) { f32x2 ab[8];
#pragma unroll
                for (int k = 0; k < 8; ++k) ab[k] = (c0 + k < c) ? ap[(size_t)(c0 + k) * 512] : (f32x2){1.f, 0.f};
#pragma unroll
                for (int k = 0; k < 8; ++k) h = ab[k][0] * h + ab[k][1]; }
            if (c == NCH - 1) { const f32x2 ab = ap[(size_t)c * 512]; out[OFF_PH + (size_t)(l * NB + b) * 512 + C.tid] = ab[0] * h + ab[1]; } }
        hin[C.tid] = h;
        __syncthreads();
        float hv[8];
#pragma unroll
        for (int e = 0; e < 8; ++e) hv[e] = hin[8 * C.lane + e];
        for (int r0 = C.wave; r0 < nvalid; r0 += 4 * NWAVES) {
            u32x4 a[4], hl[4], pl[4], g[4]; bool ok[4];
#pragma unroll
            for (int q = 0; q < 4; ++q) { const int r = r0 + 8 * q; ok[q] = r < nvalid; const size_t row = (size_t)rowbase + (ok[q] ? r : r0);
                a[q] = *((const u32x4*)(MRG + row * DM) + C.lane); hl[q] = *((const u32x4*)(MRG + row * DM + 512) + C.lane); pl[q] = *((const u32x4*)(PL + row * 512) + C.lane); g[q] = *((const u32x4*)(G + row * 512) + C.lane); }
            float av[4][8], ov[4][8], sa[4], so[4];
#pragma unroll
            for (int q = 0; q < 4; ++q) {
                const float a8[8] = {bflo(a[q].x), bfhi(a[q].x), bflo(a[q].y), bfhi(a[q].y), bflo(a[q].z), bfhi(a[q].z), bflo(a[q].w), bfhi(a[q].w)};
                const float hlv[8] = {bflo(hl[q].x), bfhi(hl[q].x), bflo(hl[q].y), bfhi(hl[q].y), bflo(hl[q].z), bfhi(hl[q].z), bflo(hl[q].w), bfhi(hl[q].w)};
                const float plv[8] = {bflo(pl[q].x), bfhi(pl[q].x), bflo(pl[q].y), bfhi(pl[q].y), bflo(pl[q].z), bfhi(pl[q].z), bflo(pl[q].w), bfhi(pl[q].w)};
                const float gv[8] = {bflo(g[q].x), bfhi(g[q].x), bflo(g[q].y), bfhi(g[q].y), bflo(g[q].z), bfhi(g[q].z), bflo(g[q].w), bfhi(g[q].w)};
                sa[q] = 0.f; so[q] = 0.f;
#pragma unroll
                for (int e = 0; e < 8; ++e) { av[q][e] = a8[e]; ov[q][e] = (hlv[e] + plv[e] * hv[e]) * gv[e]; sa[q] += a8[e] * a8[e]; so[q] += ov[q][e] * ov[q][e]; } }
#pragma unroll
            for (int o = 1; o < 64; o <<= 1) {
#pragma unroll
                for (int q = 0; q < 4; ++q) { sa[q] += __shfl_xor(sa[q], o); so[q] += __shfl_xor(so[q], o); } }
#pragma unroll
            for (int q = 0; q < 4; ++q) { if (!ok[q]) continue; const size_t row = (size_t)rowbase + r0 + 8 * q;
                const float ra = rsqrtf(sa[q] * (1.f / 512.f) + EPS), ro = rsqrtf(so[q] * (1.f / 512.f) + EPS);
                *((u32x4*)(MRG + row * DM) + C.lane) = (u32x4){cvt_pk_bf16(av[q][0] * ra, av[q][1] * ra), cvt_pk_bf16(av[q][2] * ra, av[q][3] * ra), cvt_pk_bf16(av[q][4] * ra, av[q][5] * ra), cvt_pk_bf16(av[q][6] * ra, av[q][7] * ra)};
                *((u32x4*)(MRG + row * DM + 512) + C.lane) = (u32x4){cvt_pk_bf16(ov[q][0] * ro, ov[q][1] * ro), cvt_pk_bf16(ov[q][2] * ro, ov[q][3] * ro), cvt_pk_bf16(ov[q][4] * ro, ov[q][5] * ro), cvt_pk_bf16(ov[q][6] * ro, ov[q][7] * ro)}; }
        }
    }
}
__device__ __forceinline__ void fixup_slab(const Args& A, Ctx& C, int l, int r0, unsigned* slabcnt, const unsigned* xcc_of, int pm) {
    OPQ_PTRS; asm volatile("" : "+s"(l), "+s"(r0)); asm volatile("" : "+v"(C.lane), "+v"(C.tid));
    float* hin = (float*)C.lds;
    bf16_t* MRG = (bf16_t*)(ws + WS_MRG); const bf16_t* PL = (const bf16_t*)(ws + WS_PL); const float* agg = (const float*)(ws + WS_AGG);
    const bf16_t* G = (const bf16_t*)(ws + WS_G) + (r0 >= (int)TAIL_ROW0 ? G_DELTA : 0);
    int pos1 = 64, pos2 = 64;
    if (r0 >= MV) { for (int e = C.tid; e < 64 * 128; e += NTHREADS) *((u32x4*)(MRG + (size_t)r0 * DM) + e) = (u32x4){0u, 0u, 0u, 0u}; }
    else {
        if (r0 >= MP) { hin[C.tid] = 0.f; }
        else {
            const int b0 = r0 / LP, t0 = r0 - b0 * LP, c0 = t0 >> 6;
            const int end0 = (64 * (c0 + 1) < LP ? 64 * (c0 + 1) : LP) - t0;
            float h = 0.f;
            { const f32x2* ap = (const f32x2*)agg + (size_t)b0 * NCH * 512 + C.tid; f32x2 ab[32];
#pragma unroll
                for (int k = 0; k < 32; ++k) ab[k] = (k < c0) ? ap[(size_t)k * 512] : (f32x2){1.f, 0.f};
#pragma unroll
                for (int k = 0; k < 32; ++k) h = ab[k][0] * h + ab[k][1];
                hin[C.tid] = h;
                int b = b0, c = c0, pos = end0 < 64 ? end0 : 64;
                if (c == NCH - 1) { const f32x2 abl = ap[(size_t)c * 512]; out[OFF_PH + (size_t)(l * NB + b) * 512 + C.tid] = abl[0] * h + abl[1]; }
                if (pos < 64) {
                    pos1 = pos;
                    if (t0 + pos == LP) { b = b0 + 1; c = 0; h = 0.f; } else { const f32x2 x = ap[(size_t)c * 512]; h = x[0] * h + x[1]; c = c + 1; }
                    hin[512 + C.tid] = h;
                    const int tcur = (b == b0) ? t0 + pos : 0; const int cend = (64 * (c + 1) < LP ? 64 * (c + 1) : LP) - tcur; const int len1 = cend < 64 - pos ? cend : 64 - pos;
                    if (b == b0 && c == NCH - 1) { const f32x2 abl = ap[(size_t)c * 512]; out[OFF_PH + (size_t)(l * NB + b) * 512 + C.tid] = abl[0] * h + abl[1]; }
                    pos += len1;
                    if (pos < 64) {
                        pos2 = pos; hin[1024 + C.tid] = 0.f; } } }
        }
        __syncthreads();
        for (int rr = C.wave; rr < 64; rr += 4 * NWAVES) {
            u32x4 a[4], hl[4], pl[4], g[4]; int sg[4];
#pragma unroll
            for (int q = 0; q < 4; ++q) { const int r = rr + 8 * q; const size_t row = (size_t)r0 + r; sg[q] = (r >= pos1 ? 1 : 0) + (r >= pos2 ? 1 : 0);
                a[q] = *((const u32x4*)(MRG + row * DM) + C.lane); hl[q] = *((const u32x4*)(MRG + row * DM + 512) + C.lane); pl[q] = *((const u32x4*)(PL + row * 512) + C.lane); g[q] = *((const u32x4*)(G + row * 512) + C.lane); }
            float av[4][8], ov[4][8], sa[4], so[4];
#pragma unroll
            for (int q = 0; q < 4; ++q) {
                const float* hq = hin + 512 * sg[q] + 8 * C.lane; const f32x4 h0 = *(const f32x4*)hq, h1 = *(const f32x4*)(hq + 4); const float hv[8] = {h0[0], h0[1], h0[2], h0[3], h1[0], h1[1], h1[2], h1[3]};
                const float a8[8] = {bflo(a[q].x), bfhi(a[q].x), bflo(a[q].y), bfhi(a[q].y), bflo(a[q].z), bfhi(a[q].z), bflo(a[q].w), bfhi(a[q].w)};
                const float hlv[8] = {bflo(hl[q].x), bfhi(hl[q].x), bflo(hl[q].y), bfhi(hl[q].y), bflo(hl[q].z), bfhi(hl[q].z), bflo(hl[q].w), bfhi(hl[q].w)};
                const float plv[8] = {bflo(pl[q].x), bfhi(pl[q].x), bflo(pl[q].y), bfhi(pl[q].y), bflo(pl[q].z), bfhi(pl[q].z), bflo(pl[q].w), bfhi(pl[q].w)};
                const float gv[8] = {bflo(g[q].x), bfhi(g[q].x), bflo(g[q].y), bfhi(g[q].y), bflo(g[q].z), bfhi(g[q].z), bflo(g[q].w), bfhi(g[q].w)};
                sa[q] = 0.f; so[q] = 0.f;
#pragma unroll
                for (int e = 0; e < 8; ++e) { av[q][e] = a8[e]; ov[q][e] = (hlv[e] + plv[e] * hv[e]) * gv[e]; sa[q] += a8[e] * a8[e]; so[q] += ov[q][e] * ov[q][e]; } }
#pragma unroll
            for (int o = 1; o < 64; o <<= 1) {
#pragma unroll
                for (int q = 0; q < 4; ++q) { sa[q] += __shfl_xor(sa[q], o); so[q] += __shfl_xor(so[q], o); } }
#pragma unroll
            for (int q = 0; q < 4; ++q) { const size_t row = (size_t)r0 + rr + 8 * q;
                const float ra = rsqrtf(sa[q] * (1.f / 512.f) + EPS), ro = rsqrtf(so[q] * (1.f / 512.f) + EPS);
                *((u32x4*)(MRG + row * DM) + C.lane) = (u32x4){cvt_pk_bf16(av[q][0] * ra, av[q][1] * ra), cvt_pk_bf16(av[q][2] * ra, av[q][3] * ra), cvt_pk_bf16(av[q][4] * ra, av[q][5] * ra), cvt_pk_bf16(av[q][6] * ra, av[q][7] * ra)};
                *((u32x4*)(MRG + row * DM + 512) + C.lane) = (u32x4){cvt_pk_bf16(ov[q][0] * ro, ov[q][1] * ro), cvt_pk_bf16(ov[q][2] * ro, ov[q][3] * ro), cvt_pk_bf16(ov[q][4] * ro, ov[q][5] * ro), cvt_pk_bf16(ov[q][6] * ro, ov[q][7] * ro)}; }
        }
    }
    asm volatile("s_waitcnt vmcnt(0)" ::: "memory"); __syncthreads();
    if (C.wave == 0) {
        const unsigned my = ((unsigned)__builtin_amdgcn_s_getreg((3 << 11) | 20) & 0xFu) + 1u;
        const unsigned v = (pm < 64 && C.lane < 4) ? __hip_atomic_load(xcc_of + 4 * pm + C.lane, __ATOMIC_RELAXED, __HIP_MEMORY_SCOPE_AGENT) : (pm < 64 ? my : 0u);
        if (__builtin_amdgcn_ballot_w64(v != my) != 0ull) __builtin_amdgcn_fence(__ATOMIC_RELEASE, "agent");
        asm volatile("s_waitcnt vmcnt(0)" ::: "memory");
        if (C.lane == 0) __hip_atomic_fetch_add(slabcnt + 64 * pm, 1u, __ATOMIC_RELAXED, __HIP_MEMORY_SCOPE_AGENT);
        unsigned spins = 0;
        while ((unsigned)__builtin_amdgcn_readfirstlane(__hip_atomic_load(slabcnt + 64 * pm, __ATOMIC_RELAXED, __HIP_MEMORY_SCOPE_AGENT)) < 4u) { if (++spins > (1u << 22)) break; __builtin_amdgcn_s_sleep(2); }
        __builtin_amdgcn_fence(__ATOMIC_ACQUIRE, "agent"); asm volatile("s_waitcnt vmcnt(0)" ::: "memory"); }
    __syncthreads();
}
__global__ void __launch_bounds__(NTHREADS) hymba_fwd(Args args) {
    const Args& A = args;
    extern __shared__ __attribute__((aligned(16))) unsigned char lds[];
    cg::grid_group grid = cg::this_grid();
    Ctx C;
    C.lds = lds;
    C.tid = threadIdx.x; C.lane = C.tid & 63; C.wave = __builtin_amdgcn_readfirstlane(C.tid >> 6);
    { const int bx = blockIdx.x; C.vcu = (bx % 8) * 32 + bx / 8; }
    C.gw = C.vcu * NWAVES + C.wave;
    PG8_LAS unsigned char* ring = (PG8_LAS unsigned char*)lds;
    volatile __attribute__((address_space(3))) unsigned* xb_st = (volatile __attribute__((address_space(3))) unsigned*)((PG8_LAS unsigned char*)lds + 131072);
    if (threadIdx.x < 2) xb_st[threadIdx.x] = 0u;
    __syncthreads();
    { u32x4* cz = (u32x4*)(args.ws + WS_CTL); for (int i = blockIdx.x * NTHREADS + threadIdx.x; i < (int)(CTL_BYTES / 16); i += 256 * NTHREADS) cz[i] = (u32x4){0u, 0u, 0u, 0u}; }
#ifndef NO_P0
    p0_prologue(A, C);
#endif
    grid.sync();
    XcdBarrier xbar = xcd_barrier_post((unsigned*)(args.ws + WS_CTL) + CW_XBAR, xb_st);
    if (threadIdx.x == 0) __hip_atomic_store((unsigned*)(args.ws + WS_CTL) + CW_XCC + C.vcu, xbar.x + 1u, __ATOMIC_RELAXED, __HIP_MEMORY_SCOPE_AGENT);
    for (int l = 0; l < DEPTH; ++l) {
#ifndef NO_P1
        {
            OPQ_PTRS; int ll = l; asm volatile("" : "+s"(ll)); const unsigned char* wb = ws + WS_W + (size_t)ll * W_LAYER_B; unsigned* ctl = (unsigned*)(ws + WS_CTL); float* xmeta = (float*)(ws + WS_XMETA); float* xss = (float*)(ws + WS_XSS); bf16_t* xb16 = (bf16_t*)(ws + WS_XB16); (void)ctl; (void)xmeta; (void)wb;
            pg8::Gemm g{xb16, (const bf16_t*)wb, MPAD, IN_W, DM}; pg8::GatedOrder S{C.vcu, 7, 1, ctl + CW_READY + (ll > 0 ? 2 * ll - 1 : 0) * SEAM_BANK, ctl + CW_GD16 + (ll > 0 ? 2 * ll - 1 : 0) * 1024, ll > 0 ? 32u : 0u, 0};
            pg8::EpiIn E{xss, (bf16_t*)(ws + WS_Q), (bf16_t*)(ws + WS_KP), (bf16_t*)(ws + WS_VTP), (bf16_t*)(ws + WS_KS), (bf16_t*)(ws + WS_VTS), (bf16_t*)(ws + WS_XBC), (bf16_t*)(ws + WS_G), out, ll};
            pg8::gemm_phase<pg8::EpiIn, pg8::GatedOrder, true, true>(ring, g, S, E);
        }
#endif
        xcd_barrier(xbar);
#ifndef NO_P2
        p2_mixer(A, C, l);
#endif
        xcd_barrier(xbar);
#ifndef NO_P4
        for (int round = 0; round < 2; ++round) {
            OPQ_PTRS; int ll = l; asm volatile("" : "+s"(ll)); const unsigned char* wb = ws + WS_W + (size_t)ll * W_LAYER_B; unsigned* ctl = (unsigned*)(ws + WS_CTL); float* xmeta = (float*)(ws + WS_XMETA); float* xss = (float*)(ws + WS_XSS); bf16_t* xb16 = (bf16_t*)(ws + WS_XB16); (void)ctl; (void)xmeta; (void)wb;
            pg8::Gemm g{(const bf16_t*)(ws + WS_MRG), (const bf16_t*)(wb + W_IN_B), MPAD, DM, DM}; pg8::PanelOrder S{C.vcu, round, nullptr};
            pg8::EpiRes E{out, 0, xb16, xss, A.in[IN_POSTMIX] + ll * DM, (unsigned*)(ws + WS_XBUF), ctl + CW_SEAM + (2 * ll) * SEAM_BANK, ctl + CW_READY + (2 * ll) * SEAM_BANK, ctl + CW_GD16 + (2 * ll) * 1024, ctl + CW_XCC};
            { pg8::Unit su; if (S.next(0, su)) fixup_slab(A, C, l, 256 * su.pm + 64 * su.pn, ctl + CW_SLAB + ll * SEAM_BANK, ctl + CW_XCC, su.pm); }
            pg8::gemm_phase<pg8::EpiRes, pg8::PanelOrder, false, true>(ring, g, S, E);
            __syncthreads();
        }
#endif
#ifndef NO_P6
        {
            OPQ_PTRS; int ll = l; asm volatile("" : "+s"(ll)); const unsigned char* wb = ws + WS_W + (size_t)ll * W_LAYER_B; unsigned* ctl = (unsigned*)(ws + WS_CTL); float* xmeta = (float*)(ws + WS_XMETA); float* xss = (float*)(ws + WS_XSS); bf16_t* xb16 = (bf16_t*)(ws + WS_XB16); (void)ctl; (void)xmeta; (void)wb;
            pg8::Gemm g{xb16, (const bf16_t*)(wb + W_IN_B + W_OUT_B), MPAD, 2 * D_FF, DM}; pg8::GatedOrder S{C.vcu, 22, 2, ctl + CW_READY + (2 * ll) * SEAM_BANK, ctl + CW_GD16 + (2 * ll) * 1024, 32u, 0};
            pg8::EpiGU E{xss, (bf16_t*)(ws + WS_HACT)};
            pg8::gemm_phase<pg8::EpiGU, pg8::GatedOrder, true, true>(ring, g, S, E);
            __syncthreads();
            if (C.wave == 0) { const unsigned my = ((unsigned)__builtin_amdgcn_s_getreg((3 << 11) | 20) & 0xFu) + 1u;
                const unsigned v = C.lane < 32 ? __hip_atomic_load(ctl + CW_XCC + (C.vcu & ~31) + C.lane, __ATOMIC_RELAXED, __HIP_MEMORY_SCOPE_AGENT) : my;
                if (__builtin_amdgcn_ballot_w64(v != my) != 0ull) __builtin_amdgcn_fence(__ATOMIC_RELEASE, "agent");
                asm volatile("s_waitcnt vmcnt(0)" ::: "memory");
                if (C.lane == 0) __hip_atomic_fetch_add(ctl + CW_GRP + ll * 512 + 64 * (C.vcu >> 5), 1u, __ATOMIC_RELAXED, __HIP_MEMORY_SCOPE_AGENT); }
        }
#endif
#ifndef NO_P7
        for (int round = 0; round < 2; ++round) {
            OPQ_PTRS; int ll = l; asm volatile("" : "+s"(ll)); const unsigned char* wb = ws + WS_W + (size_t)ll * W_LAYER_B; unsigned* ctl = (unsigned*)(ws + WS_CTL); float* xmeta = (float*)(ws + WS_XMETA); float* xss = (float*)(ws + WS_XSS); bf16_t* xb16 = (bf16_t*)(ws + WS_XB16); (void)ctl; (void)xmeta; (void)wb;
            pg8::Gemm g{(const bf16_t*)(ws + WS_HACT), (const bf16_t*)(wb + W_IN_B + W_OUT_B + W_GU_B), MPAD, DM, D_FF}; pg8::PanelOrder S{C.vcu, round, ctl + CW_GRP + ll * 512};
            pg8::EpiRes E{out, ll == DEPTH - 1 ? 1 : 0, xb16, xss, A.in[IN_POSTFFN] + ll * DM, (unsigned*)(ws + WS_XBUF), ctl + CW_SEAM + (2 * ll + 1) * SEAM_BANK, ctl + CW_READY + (2 * ll + 1) * SEAM_BANK, ctl + CW_GD16 + (2 * ll + 1) * 1024, ctl + CW_XCC};
            pg8::gemm_phase<pg8::EpiRes, pg8::PanelOrder, false, true>(ring, g, S, E);
            __syncthreads();
        }
#endif
    }
}

extern "C" void kernel_launch(void* const* d_in, const int* in_sizes, int n_in, void* d_out, int out_size, void* d_ws, size_t ws_size, hipStream_t stream) {
    static int grid = 0;
    if (grid == 0) {
        if (n_in != 26 || ws_size < WS_END) { fprintf(stderr, "kernel_launch: unexpected inputs (n_in %d, ws %zu)\n", n_in, ws_size); grid = -1; return; }
        int dev = 0, cus = 0, per_cu = 0;
        (void)hipGetDevice(&dev); (void)hipDeviceGetAttribute(&cus, hipDeviceAttributeMultiprocessorCount, dev);
        if (hipFuncSetAttribute((const void*)hymba_fwd, hipFuncAttributeMaxDynamicSharedMemorySize, LDS_BYTES) != hipSuccess) { fprintf(stderr, "kernel_launch: hipFuncSetAttribute failed\n"); grid = -1; return; }
        if (hipOccupancyMaxActiveBlocksPerMultiprocessor(&per_cu, (const void*)hymba_fwd, NTHREADS, LDS_BYTES) != hipSuccess || per_cu < 1) { fprintf(stderr, "kernel_launch: occupancy query says %d\n", per_cu); grid = -1; return; }
        if (cus < 256) { fprintf(stderr, "kernel_launch: needs 256 CUs, device has %d\n", cus); grid = -1; return; }
        grid = 256;
    }
    if (grid < 0) return;
    Args a{};
    for (int i = 0; i < 26; ++i) a.in[i] = (const float*)d_in[i];
    a.out = (float*)d_out; a.ws = (unsigned char*)d_ws;
    void* kargs[] = {&a};
    hipError_t e = hipLaunchCooperativeKernel((const void*)hymba_fwd, dim3(grid), dim3(NTHREADS), kargs, LDS_BYTES, stream);
    if (e != hipSuccess) fprintf(stderr, "cooperative launch failed: %s\n", hipGetErrorString(e));
}
```
